# Optimizing an MI355X kernel written in HIP

```python
import jax, jax.numpy as jnp
from jax import lax
import numpy as np

D_MODEL = 4096
BATCH = 4
SEQ = 2048
DEPTH = 1

N_ATTN_HEADS = 16
HEAD_DIM = 128
ATTN_WIDTH = N_ATTN_HEADS * HEAD_DIM
MOBA_BLOCK = 256
MOBA_TOPK = 3
QUERY_BLOCK = 128
ROPE_THETA = 10000.0
LRU_WIDTH = 2048
LRU_BLOCKS = 16
LRU_BLOCK_WIDTH = LRU_WIDTH // LRU_BLOCKS
LRU_C = 8.0
CONV_WIDTH = 4
D_FF = 11008
MACARON_WEIGHT = 0.5
NORM_EPS = 1e-6
IN_SIZES = (ATTN_WIDTH, ATTN_WIDTH, ATTN_WIDTH, LRU_WIDTH, LRU_WIDTH, D_MODEL, D_MODEL)
IN_COLS = int(sum(IN_SIZES))
IN_SPLITS = tuple(int(s) for s in np.cumsum(IN_SIZES)[:-1])

kernel_name = "hybrid_moba_rglru_macaron_block"


def rms_norm(x, g):
    xf = x.astype(jnp.float32)
    y = xf * lax.rsqrt(jnp.mean(xf * xf, axis=-1, keepdims=True) + NORM_EPS)
    return (y * g.astype(jnp.float32)).astype(x.dtype)


def swiglu(x, w_gate, w_up, w_down):
    return (jax.nn.silu(x @ w_gate) * (x @ w_up)) @ w_down


def apply_rope(t):
    s, hd = t.shape[1], t.shape[-1]
    inv_freq = ROPE_THETA ** (-jnp.arange(0, hd, 2, dtype=jnp.float32) / hd)
    ang = jnp.arange(s, dtype=jnp.float32)[:, None] * inv_freq[None, :]
    cos = jnp.cos(ang)[None, :, None, :]
    sin = jnp.sin(ang)[None, :, None, :]
    tf = t.astype(jnp.float32)
    t1, t2 = tf[..., : hd // 2], tf[..., hd // 2:]
    return jnp.concatenate([t1 * cos - t2 * sin, t2 * cos + t1 * sin], axis=-1).astype(t.dtype)


def moba_attention(q, k, v):
    b, s, h, hd = q.shape
    s_pad = -(-s // MOBA_BLOCK) * MOBA_BLOCK
    pad = ((0, 0), (0, s_pad - s), (0, 0), (0, 0))
    q, k, v = jnp.pad(q, pad), jnp.pad(k, pad), jnp.pad(v, pad)
    nb = s_pad // MOBA_BLOCK
    nqb = s_pad // QUERY_BLOCK
    q_per_kblock = MOBA_BLOCK // QUERY_BLOCK
    topk = min(MOBA_TOPK, nb)
    scale = hd ** -0.5

    kb = k.reshape(b, nb, MOBA_BLOCK, h, hd).transpose(3, 0, 1, 2, 4)
    vb = v.reshape(b, nb, MOBA_BLOCK, h, hd).transpose(3, 0, 1, 2, 4)
    k_mean = jnp.mean(kb.astype(jnp.float32), axis=3)
    qh = q.transpose(2, 0, 1, 3)

    n_past = jnp.arange(s_pad) // MOBA_BLOCK
    past = jnp.arange(nb)[None, :] < n_past[:, None]
    gate = jnp.einsum('hbsd,hbnd->hbsn', qh.astype(jnp.float32), k_mean)
    gate = jnp.where(past, gate, -jnp.inf)
    _, sel = lax.top_k(gate, topk)
    valid = sel < n_past[:, None]

    def to_steps(t):
        t = t.reshape(h, b, nqb, QUERY_BLOCK, *t.shape[3:])
        t = jnp.moveaxis(t, 2, 1)
        return t.reshape(h * nqb, b, QUERY_BLOCK, *t.shape[4:])

    head_idx = jnp.repeat(jnp.arange(h), nqb)
    qblk_idx = jnp.tile(jnp.arange(nqb), h)
    b_idx = jnp.arange(b)[:, None, None]
    n_sel = topk * MOBA_BLOCK

    def step(args):
        hi, qi, qs, ss, vs = args
        kh, vh = kb[hi], vb[hi]
        k_sel = kh[b_idx, ss]
        v_sel = vh[b_idx, ss]
        j = qi // q_per_kblock
        k_own = lax.dynamic_index_in_dim(kh, j, axis=1, keepdims=False)
        v_own = lax.dynamic_index_in_dim(vh, j, axis=1, keepdims=False)
        s_sel = jnp.einsum('bqd,bqkcd->bqkc', qs, k_sel, preferred_element_type=jnp.float32) * scale
        s_sel = jnp.where(vs[..., None], s_sel, -jnp.inf).reshape(b, QUERY_BLOCK, n_sel)
        q_pos = qi * QUERY_BLOCK + jnp.arange(QUERY_BLOCK)
        k_pos = j * MOBA_BLOCK + jnp.arange(MOBA_BLOCK)
        s_own = jnp.einsum('bqd,bcd->bqc', qs, k_own, preferred_element_type=jnp.float32) * scale
        s_own = jnp.where(k_pos[None, None, :] <= q_pos[None, :, None], s_own, -jnp.inf)
        p = jax.nn.softmax(jnp.concatenate([s_sel, s_own], axis=-1), axis=-1)
        p_sel = p[..., :n_sel].reshape(b, QUERY_BLOCK, topk, MOBA_BLOCK).astype(v.dtype)
        p_own = p[..., n_sel:].astype(v.dtype)
        return (jnp.einsum('bqkc,bqkcd->bqd', p_sel, v_sel)
                + jnp.einsum('bqc,bcd->bqd', p_own, v_own))

    out = lax.map(step, (head_idx, qblk_idx, to_steps(qh), to_steps(sel), to_steps(valid)))
    out = out.reshape(h, nqb, b, QUERY_BLOCK, hd).transpose(2, 1, 3, 0, 4).reshape(b, s_pad, h * hd)
    return out[:, :s]


def causal_depthwise_conv(x, w, bias):
    s = x.shape[1]
    xp = jnp.pad(x, ((0, 0), (CONV_WIDTH - 1, 0), (0, 0)))
    y = bias
    for tap in range(CONV_WIDTH):
        y = y + xp[:, tap:tap + s] * w[tap]
    return y


def _linear_combine(c1, c2):
    a1, b1 = c1
    a2, b2 = c2
    return a1 * a2, a2 * b1 + b2


def rg_lru(x, w_a, b_a, w_x, b_x, lam):
    b, s, w = x.shape
    xb = x.reshape(b, s, LRU_BLOCKS, LRU_BLOCK_WIDTH)
    r = jax.nn.sigmoid((jnp.einsum('bsnc,ncd->bsnd', xb, w_a).reshape(b, s, w) + b_a).astype(jnp.float32))
    i = jax.nn.sigmoid((jnp.einsum('bsnc,ncd->bsnd', xb, w_x).reshape(b, s, w) + b_x).astype(jnp.float32))
    log_a = -LRU_C * r * jax.nn.softplus(-lam.astype(jnp.float32))
    a = jnp.exp(log_a)
    u = x.astype(jnp.float32) * i * jnp.sqrt(-jnp.expm1(2.0 * log_a))
    _, hs = lax.associative_scan(_linear_combine, (a, u), axis=1)
    return hs.astype(x.dtype)


def hybrid_mixer(hn, w_in, conv_w, conv_b, rg_w_a, rg_b_a, rg_w_x, rg_b_x, lru_lambda,
                 w_attn_out, w_rec_out, w_o):
    b, s, _ = hn.shape
    proj = hn @ w_in
    q, k, v, x_rec, x_gate, g_a, g_b = jnp.split(proj, IN_SPLITS, axis=-1)
    q = apply_rope(q.reshape(b, s, N_ATTN_HEADS, HEAD_DIM))
    k = apply_rope(k.reshape(b, s, N_ATTN_HEADS, HEAD_DIM))
    v = v.reshape(b, s, N_ATTN_HEADS, HEAD_DIM)
    y_a = moba_attention(q, k, v) @ w_attn_out
    x_rec = causal_depthwise_conv(x_rec, conv_w, conv_b)
    y_rec = rg_lru(x_rec, rg_w_a, rg_b_a, rg_w_x, rg_b_x, lru_lambda) * jax.nn.gelu(x_gate)
    y_b = y_rec @ w_rec_out
    merged = jax.nn.sigmoid(g_a) * y_a + jax.nn.sigmoid(g_b) * y_b
    return merged @ w_o


def setup_inputs(seed: int = 0) -> dict:
    key = jax.random.key(seed)
    ks = jax.random.split(key, 26)
    f32 = jnp.float32

    def normal(k, shape, fan_in):
        return jax.random.normal(k, (DEPTH,) + shape, f32) * (fan_in ** -0.5)

    def gain(k):
        return 1.0 + 0.05 * jax.random.normal(k, (DEPTH, D_MODEL), f32)

    def small(k, shape):
        return 0.01 * jax.random.normal(k, (DEPTH,) + shape, f32)

    a8 = jax.random.uniform(ks[14], (DEPTH, LRU_WIDTH), f32, 0.9, 0.999)
    a_base = a8 ** (1.0 / LRU_C)
    lru_lambda = jnp.log(a_base) - jnp.log1p(-a_base)
    return {
        'x': jax.random.normal(ks[0], (BATCH, SEQ, D_MODEL), f32),
        'ffn1_pre_g': gain(ks[1]),
        'ffn1_w_gate': normal(ks[2], (D_MODEL, D_FF), D_MODEL),
        'ffn1_w_up': normal(ks[3], (D_MODEL, D_FF), D_MODEL),
        'ffn1_w_down': normal(ks[4], (D_FF, D_MODEL), D_FF),
        'ffn1_post_g': gain(ks[5]),
        'mix_pre_g': gain(ks[6]),
        'w_in': normal(ks[7], (D_MODEL, IN_COLS), D_MODEL),
        'conv_w': normal(ks[8], (CONV_WIDTH, LRU_WIDTH), CONV_WIDTH),
        'conv_b': small(ks[9], (LRU_WIDTH,)),
        'rg_w_a': normal(ks[10], (LRU_BLOCKS, LRU_BLOCK_WIDTH, LRU_BLOCK_WIDTH), LRU_BLOCK_WIDTH),
        'rg_b_a': small(ks[11], (LRU_WIDTH,)),
        'rg_w_x': normal(ks[12], (LRU_BLOCKS, LRU_BLOCK_WIDTH, LRU_BLOCK_WIDTH), LRU_BLOCK_WIDTH),
        'rg_b_x': small(ks[13], (LRU_WIDTH,)),
        'lru_lambda': lru_lambda,
        'w_attn_out': normal(ks[15], (ATTN_WIDTH, D_MODEL), ATTN_WIDTH),
        'w_rec_out': normal(ks[16], (LRU_WIDTH, D_MODEL), LRU_WIDTH),
        'w_o': normal(ks[17], (D_MODEL, D_MODEL), D_MODEL),
        'mix_post_g': gain(ks[18]),
        'ffn2_pre_g': gain(ks[19]),
        'ffn2_w_gate': normal(ks[20], (D_MODEL, D_FF), D_MODEL),
        'ffn2_w_up': normal(ks[21], (D_MODEL, D_FF), D_MODEL),
        'ffn2_w_down': normal(ks[22], (D_FF, D_MODEL), D_FF),
        'ffn2_post_g': gain(ks[23]),
    }


def reference(x, ffn1_pre_g, ffn1_w_gate, ffn1_w_up, ffn1_w_down, ffn1_post_g,
              mix_pre_g, w_in, conv_w, conv_b, rg_w_a, rg_b_a, rg_w_x, rg_b_x, lru_lambda,
              w_attn_out, w_rec_out, w_o, mix_post_g,
              ffn2_pre_g, ffn2_w_gate, ffn2_w_up, ffn2_w_down, ffn2_post_g):
    for l in range(DEPTH):
        f = swiglu(rms_norm(x, ffn1_pre_g[l]), ffn1_w_gate[l], ffn1_w_up[l], ffn1_w_down[l])
        x = x + MACARON_WEIGHT * rms_norm(f, ffn1_post_g[l])
        m = hybrid_mixer(rms_norm(x, mix_pre_g[l]), w_in[l], conv_w[l], conv_b[l],
                         rg_w_a[l], rg_b_a[l], rg_w_x[l], rg_b_x[l], lru_lambda[l],
                         w_attn_out[l], w_rec_out[l], w_o[l])
        x = x + rms_norm(m, mix_post_g[l])
        f = swiglu(rms_norm(x, ffn2_pre_g[l]), ffn2_w_gate[l], ffn2_w_up[l], ffn2_w_down[l])
        x = x + MACARON_WEIGHT * rms_norm(f, ffn2_post_g[l])
    return x
```

```cpp
#include <hip/hip_runtime.h>
#include <cstdio>
#include <cstdint>

#ifndef MK_PER_PHASE
#define MK_PER_PHASE 0
#endif

__device__ __forceinline__ int tid_of(int wv) { return wv * 64 + (int)__builtin_amdgcn_mbcnt_hi(~0u, __builtin_amdgcn_mbcnt_lo(~0u, 0u)); }
namespace pg8 {
#define PG8_LAS __attribute__((address_space(3)))
typedef unsigned short bf16_t;
typedef short bf16x8 __attribute__((ext_vector_type(8)));
typedef float f32x4 __attribute__((ext_vector_type(4)));
typedef unsigned u32x4 __attribute__((ext_vector_type(4)));
typedef int i32x4 __attribute__((ext_vector_type(4)));
typedef int i32x8 __attribute__((ext_vector_type(8)));
constexpr int BM = 256, BK = 64, HALF = 128, HTB = HALF * BK * 2, STAGE_BYTES = 8 * HTB, NXCD = 8, WGM = 8;

__host__ __device__ __forceinline__ int lds_byte(int r, int c) { const int st = (r >> 4) * 2 + (c >> 5), rr = r & 15, cc = c & 31, ob = rr * 64 + cc * 2; return st * 1024 + (ob ^ (((ob >> 9) & 1) << 5)); }
__host__ __device__ __forceinline__ void stage_rc(int b, int& R, int& C) { const int st = b / 1024, sb = b % 1024, swz = sb ^ (((sb >> 9) & 1) << 5); R = (st >> 1) * 16 + swz / 64; C = (st & 1) * 32 + (swz % 64) / 2; }
__host__ __device__ __forceinline__ int perm32(int rho) { const int n = rho >> 4, i = rho & 15; return 8 * (i >> 2) + 4 * n + (i & 3); }

struct Unit { int pm, pn, seg; };
struct Gemm { const bf16_t* A0; const bf16_t* A1; const bf16_t* B0; const bf16_t* B1; int lda, ldb, nt; int kstepB; size_t tileB; int nb; };
__host__ __device__ __forceinline__ Gemm gemm_tiledB(const bf16_t* A0, const bf16_t* A1, const bf16_t* B0, const bf16_t* B1, int lda, int K) { return Gemm{A0, A1, B0, B1, lda, 64, K / 64, 32768, (size_t)256 * K, 0}; }
__host__ __device__ __forceinline__ Gemm gemm_chunkB(const bf16_t* A0, const bf16_t* A1, const bf16_t* B0, const bf16_t* B1, int lda, int K, int) { return Gemm{A0, A1, B0, B1, lda, 0, K / 64, 32768, (size_t)256 * K, 256}; }
__host__ __device__ __forceinline__ Gemm gemm_chunkB8(const void* A, const void* B, int lda, int K, size_t tile_bytes = 0) { return Gemm{(const bf16_t*)A, (const bf16_t*)A, (const bf16_t*)B, (const bf16_t*)B, lda, 0, K / 128, 32768, tile_bytes ? tile_bytes / 2 : (size_t)128 * K, 256}; }
__host__ __device__ __forceinline__ Gemm gemm_rowB(const bf16_t* A0, const bf16_t* A1, const bf16_t* B0, const bf16_t* B1, int lda, int ldb, int K) { return Gemm{A0, A1, B0, B1, lda, ldb, K / 64, 128, (size_t)256 * ldb, 0}; }

struct StaticOrder {
    int nM, nN, nwg, G, c, pn0, gap_at, gap_len, ibeg, iend;
    __host__ __device__ void init(int M, int N, int G_, int c_, int pn0_ = 0, int gap_at_ = 1 << 30, int gap_len_ = 0) { nM = M / BM; nN = N / BM; nwg = nM * nN; G = G_; c = c_; pn0 = pn0_; gap_at = gap_at_; gap_len = gap_len_; ibeg = 0; iend = 1 << 30; }
    __host__ __device__ bool tile(long L, Unit& u) const {
        if (L >= nwg) return false;
        int wgid = (int)L; { const int q = nwg / NXCD, r = nwg % NXCD, xcd = wgid % NXCD, off = wgid / NXCD; wgid = (xcd < r ? xcd * (q + 1) : r * (q + 1) + (xcd - r) * q) + off; }
        const int nig = WGM * nN, gid = wgid / nig, fm = gid * WGM, gsz = (nM - fm) < WGM ? (nM - fm) : WGM;
        u.pm = fm + ((wgid % nig) % gsz); { const int p = (wgid % nig) / gsz; u.pn = pn0 + p + (p >= gap_at ? gap_len : 0); } return true;
    }
    __host__ __device__ bool next(int i, Unit& u) const { u.seg = 0; const int idx = ibeg + i; if (idx >= iend) return false; return tile((long)idx * G + c, u); }
};
struct StaticOrder2 : StaticOrder {
    __host__ __device__ bool next(int i, Unit& u) const { const bool ok = tile((long)(i >> 1) * G + c, u); u.seg = i & 1; return ok; }
};

typedef __bf16 bf16x2_t __attribute__((ext_vector_type(2)));
typedef float f32x2_t __attribute__((ext_vector_type(2)));
__device__ __forceinline__ unsigned cvt_pk_bf16(float lo, float hi) { const f32x2_t f = {lo, hi}; const bf16x2_t b = __builtin_convertvector(f, bf16x2_t); return __builtin_bit_cast(unsigned, b); }

template <int MODE, bool FP8> __device__ __forceinline__ const char* a_ptr(const Gemm& g, const Unit& u) {
    const bf16_t* A = (MODE == 1 && u.seg) ? g.A1 : g.A0; size_t off = (size_t)u.pm * BM * g.lda;
    return FP8 ? (const char*)A + off : (const char*)(A + off); }
template <int MODE> __device__ __forceinline__ const char* b_ptr(const Gemm& g, const Unit& u) {
    const bf16_t* B = (MODE == 1 && u.seg) ? g.B1 : g.B0; return (const char*)(B + (size_t)u.pn * g.tileB); }

template <class Epi, class Sched, int MODE, bool ALIGN_EPI, bool FP8 = false, bool I8 = false>
__device__ __forceinline__ void gemm_phase(PG8_LAS unsigned char* lds, const Gemm g, const Sched& S, const Epi& E, const int wv) {
    int tid_ = tid_of(wv); asm volatile("" : "+v"(tid_));
    const int tid = tid_, wid = __builtin_amdgcn_readfirstlane(tid >> 6), lane = tid & 63, wr = wid >> 2, wc = wid & 3, fr = lane & 15, fq = lane >> 4;
    const int nt = g.nt;
    constexpr bool CHB = true;
    unsigned voffA[2], voffB[2];
#pragma unroll
    for (int i = 0; i < 2; ++i) { int R, C; stage_rc(tid * 16 + i * 8192, R, C); const int Rb = Epi::PERM ? ((R & ~31) + perm32(R & 31)) : R;
        voffA[i] = (FP8 || I8) ? (unsigned)(R * g.lda + C * 2) : (unsigned)(R * g.lda + C) * 2u; voffB[i] = CHB ? (unsigned)((4 * i + (wid >> 1)) * 256 + (wid & 1) * 64 + lane) * 16u : (unsigned)(Rb * g.ldb + C) * 2u; }
    const size_t kstep = (size_t)(BK * 2), kstepB = (size_t)g.kstepB;
    const size_t hstepA = (size_t)HALF * g.lda * ((FP8 || I8) ? 1 : 2), hstepB = g.nb ? (size_t)HALF * 16 : (size_t)HALF * g.ldb * 2;
    unsigned voffAh[2], voffBh[2];
#pragma unroll
    for (int i = 0; i < 2; ++i) { voffAh[i] = voffA[i] + (unsigned)hstepA; voffBh[i] = voffB[i] + (unsigned)hstepB; }
    const unsigned ldsw = (unsigned)wid * 1024u;
    const int aoff = lds_byte(wr * 64 + fr, fq * 8), boff = CHB ? (fq * 128 + wc * 32 + fr) * 16 : lds_byte(wc * 32 + fr, fq * 8);
#define PG8_SA(b, h) (((b) * 2 + (h)) * HTB)
#define PG8_SB(b, h) ((4 + (b) * 2 + (h)) * HTB)
#define PG8_STAGE(bufoff, gbase, voff) do { _Pragma("unroll") for (int _i = 0; _i < 2; ++_i) \
        __builtin_amdgcn_global_load_lds((const unsigned*)((const char*)(gbase) + (voff)[_i]), (PG8_LAS unsigned*)(lds + (bufoff) + ldsw + _i * 8192), 16, 0, 0); } while (0)
#define PG8_LD16(p) (*(const PG8_LAS i32x4*)(p))
#define PG8_LDA(dst, b, h) do { if constexpr (FP8) { _Pragma("unroll") for (int m = 0; m < 4; ++m) dst##8[m] = __builtin_shufflevector(PG8_LD16(lds + PG8_SA(b, h) + aoff + m * 2048), PG8_LD16(lds + PG8_SA(b, h) + aoff + m * 2048 + 1024), 0, 1, 2, 3, 4, 5, 6, 7); } else { \
        _Pragma("unroll") for (int m = 0; m < 4; ++m) _Pragma("unroll") for (int k = 0; k < 2; ++k) dst[m][k] = *(const PG8_LAS bf16x8*)(lds + PG8_SA(b, h) + aoff + m * 2048 + k * 1024); } } while (0)
#define PG8_LDB(dst, b, h) do { if constexpr (FP8) { _Pragma("unroll") for (int n = 0; n < 2; ++n) dst##8[n] = __builtin_shufflevector(PG8_LD16(lds + PG8_SB(b, h) + boff + n * 256), PG8_LD16(lds + PG8_SB(b, h) + boff + n * 256 + 8192), 0, 1, 2, 3, 4, 5, 6, 7); } else { \
        _Pragma("unroll") for (int n = 0; n < 2; ++n) _Pragma("unroll") for (int k = 0; k < 2; ++k) dst[n][k] = *(const PG8_LAS bf16x8*)(lds + PG8_SB(b, h) + boff + n * (CHB ? 256 : 2048) + k * (CHB ? 8192 : 1024)); } } while (0)
#define PG8_MMA(ai, bj, At, Bt) do { __builtin_amdgcn_s_setprio(1); if constexpr (FP8) { _Pragma("unroll") for (int m = 0; m < 4; ++m) _Pragma("unroll") for (int n = 0; n < 2; ++n) \
        acc[ai][bj][m][n] = __builtin_amdgcn_mfma_scale_f32_16x16x128_f8f6f4(Bt##8[n], At##8[m], acc[ai][bj][m][n], 0, 0, 0, 0, 0, 0); } else { \
        _Pragma("unroll") for (int m = 0; m < 4; ++m) _Pragma("unroll") for (int n = 0; n < 2; ++n) _Pragma("unroll") for (int k = 0; k < 2; ++k) { \
        if constexpr (I8) acc[ai][bj][m][n] = __builtin_bit_cast(f32x4, __builtin_amdgcn_mfma_i32_16x16x64_i8(__builtin_bit_cast(i32x4, Bt[n][k]), __builtin_bit_cast(i32x4, At[m][k]), __builtin_bit_cast(i32x4, acc[ai][bj][m][n]), 0, 0, 0)); \
        else acc[ai][bj][m][n] = __builtin_amdgcn_mfma_f32_16x16x32_bf16(Bt[n][k], At[m][k], acc[ai][bj][m][n], 0, 0, 0); } } __builtin_amdgcn_s_setprio(0); } while (0)
#define PG8_WAIT_V(n) asm volatile("s_waitcnt vmcnt(" #n ")" ::: "memory")
#define PG8_WAIT_L(n) asm volatile("s_waitcnt lgkmcnt(" #n ")" ::: "memory")
#define PG8_BAR __builtin_amdgcn_s_barrier()
#define PG8_SCHED __builtin_amdgcn_sched_barrier(0)
    Unit cur, nxt; int ui = 0;
    if (!S.next(0, cur)) return;
    f32x4 acc[2][2][4][2];
#pragma unroll
    for (int a = 0; a < 2; ++a)
#pragma unroll
        for (int b = 0; b < 2; ++b)
#pragma unroll
            for (int m = 0; m < 4; ++m)
#pragma unroll
                for (int n = 0; n < 2; ++n) acc[a][b][m][n] = (f32x4){0.f, 0.f, 0.f, 0.f};
    bf16x8 At[4][2], B0[2][2], B1[2][2]; i32x8 At8[4], B08[2], B18[2];
    const char* cA = a_ptr<MODE, (FP8 || I8)>(g, cur); const char* cB = b_ptr<MODE>(g, cur);
    PG8_STAGE(PG8_SB(0, 0), cB, voffB); PG8_STAGE(PG8_SB(0, 1), cB, voffBh); PG8_STAGE(PG8_SA(0, 0), cA, voffA); PG8_STAGE(PG8_SA(0, 1), cA, voffAh);
    if (wr == 1) PG8_BAR;
    PG8_WAIT_V(2); PG8_BAR;
    PG8_STAGE(PG8_SB(1, 0), cB + kstepB, voffB); PG8_STAGE(PG8_SA(1, 0), cA + kstep, voffA); PG8_STAGE(PG8_SB(1, 1), cB + kstepB, voffBh);
    PG8_WAIT_V(6); PG8_BAR;
    for (;;) {
        const bool has_next = S.next(ui + 1, nxt);
        float rsv[8];
        if constexpr (Epi::HAS_RS) E.load_rs(cur, wr, fr, rsv);
        const char* nA = has_next ? a_ptr<MODE, (FP8 || I8)>(g, nxt) : cA; const char* nB = has_next ? b_ptr<MODE>(g, nxt) : cB;
#pragma nounroll
        for (int t = 0; t < nt; t += 2) {
            const bool last = (t == nt - 2);
            asm volatile("" : "+v"(voffA[0]), "+v"(voffA[1]), "+v"(voffB[0]), "+v"(voffB[1]), "+v"(voffAh[0]), "+v"(voffAh[1]), "+v"(voffBh[0]), "+v"(voffBh[1]));
            const char* a1 = cA + (size_t)(t + 1) * kstep;
            const char* a2 = last ? nA : cA + (size_t)(t + 2) * kstep; const char* b2 = last ? nB : cB + (size_t)(t + 2) * kstepB;
            const char* a3 = a2 + kstep; const char* b3 = b2 + kstepB;
            asm volatile("" : "+s"(a1), "+s"(a2), "+s"(a3), "+s"(b2), "+s"(b3));
            PG8_LDB(B0, 0, 0); PG8_LDB(B1, 0, 1); PG8_SCHED; PG8_LDA(At, 0, 0); PG8_STAGE(PG8_SA(1, 1), a1, voffAh);
            PG8_WAIT_V(8); PG8_WAIT_L(0); PG8_BAR; PG8_MMA(0, 0, At, B0); PG8_MMA(0, 1, At, B1); PG8_BAR; PG8_SCHED;
            PG8_LDA(At, 0, 1); PG8_STAGE(PG8_SB(0, 0), b2, voffB); PG8_STAGE(PG8_SB(0, 1), b2, voffBh); PG8_STAGE(PG8_SA(0, 0), a2, voffA);
            PG8_WAIT_V(8); PG8_WAIT_L(0); PG8_BAR; PG8_MMA(1, 0, At, B0); PG8_MMA(1, 1, At, B1); PG8_BAR; PG8_SCHED;
            PG8_LDB(B0, 1, 0); PG8_LDB(B1, 1, 1); PG8_SCHED; PG8_LDA(At, 1, 0); PG8_STAGE(PG8_SA(0, 1), a2, voffAh);
            PG8_WAIT_V(8); PG8_WAIT_L(0); PG8_BAR; PG8_MMA(0, 0, At, B0); PG8_MMA(0, 1, At, B1); PG8_BAR; PG8_SCHED;
            PG8_LDA(At, 1, 1); PG8_STAGE(PG8_SB(1, 0), b3, voffB); PG8_STAGE(PG8_SB(1, 1), b3, voffBh); PG8_STAGE(PG8_SA(1, 0), a3, voffA);
            PG8_WAIT_V(8); PG8_WAIT_L(0); PG8_BAR; PG8_MMA(1, 0, At, B0); PG8_MMA(1, 1, At, B1); PG8_BAR; PG8_SCHED;
        }
        if constexpr (ALIGN_EPI) { if (wr == 0) PG8_BAR; }
        { int te = tid_of(wv); asm volatile("" : "+v"(te)); const int fre = te & 15, fqe = (te & 63) >> 4;
          if constexpr (Epi::HAS_RS) E(acc, cur, wr, wc, fre, fqe, rsv); else E(acc, cur, wr, wc, fre, fqe); }
        if (!has_next) break;
        if (!(MODE == 1 && cur.seg == 0)) {
#pragma unroll
        for (int a = 0; a < 2; ++a)
#pragma unroll
            for (int b = 0; b < 2; ++b)
#pragma unroll
                for (int m = 0; m < 4; ++m)
#pragma unroll
                    for (int n = 0; n < 2; ++n) acc[a][b][m][n] = (f32x4){0.f, 0.f, 0.f, 0.f};
        }
        cur = nxt; cA = nA; cB = nB; ++ui;
        if constexpr (ALIGN_EPI) { if (wr == 1) PG8_BAR; }
    }
    PG8_WAIT_V(0);
    if constexpr (!ALIGN_EPI) { if (wr == 0) PG8_BAR; }
    PG8_BAR;
#undef PG8_SA
#undef PG8_SB
#undef PG8_STAGE
#undef PG8_LDA
#undef PG8_LDB
#undef PG8_MMA
#undef PG8_WAIT_V
#undef PG8_WAIT_L
#undef PG8_BAR
#undef PG8_SCHED
}
}


namespace att {
constexpr int D = 128, LD = 2048;
constexpr float SCALE = 0.08838834764831845f, THR = 8.f;
constexpr bool WSKIP = false;
constexpr int NW = 8, QBLK = 32, KVBLK = 64, QB = NW * QBLK;
constexpr int SHM_V = KVBLK * D * 2, SHM_K = KVBLK * D * 2;
constexpr int LDS_BYTES = 2 * SHM_V + 2 * SHM_K + NW * 64 * 4;
typedef short bf16x8 __attribute__((ext_vector_type(8)));
typedef short s16x4 __attribute__((ext_vector_type(4)));
typedef float f32x16 __attribute__((ext_vector_type(16)));
typedef float f32x4 __attribute__((ext_vector_type(4)));
typedef unsigned u32x4 __attribute__((ext_vector_type(4)));
template <class A, class Bt> struct same_t { static constexpr bool v = false; };
template <class A> struct same_t<A, A> { static constexpr bool v = true; };
#define KSWZ(row, colB) ((row) * 256 + ((colB) ^ (((row) & 7) << 4)))
#define SBAR() __builtin_amdgcn_sched_barrier(0)
__device__ __forceinline__ int v_st(int k, int c) { const int kk = (k & ~0xC) | ((k & 4) << 1) | ((k & 8) >> 1); return ((kk >> 3) * 4 + (c >> 5)) * 512 + ((kk & 7) * 32 + (c & 31)) * 2; }
__device__ __forceinline__ int v_rd_base(int lane) { return ((lane & 3) << 3) | (((lane >> 2) & 3) << 6) | (((lane >> 4) & 1) << 5) | (((lane >> 5) & 1) << 8); }
constexpr int v_rd_off(int d0, int ks, int half) { return d0 * 512 + ks * 4096 + half * 2048; }
__device__ __forceinline__ int crow(int r, int hi) { return (r & 3) + 8 * (r >> 2) + 4 * hi; }
__device__ __forceinline__ unsigned cvtpk(float lo, float hi) { return pg8::cvt_pk_bf16(lo, hi); }
__device__ __forceinline__ bf16x8 pack8(f32x4 a, f32x4 b) {
    u32x4 w = {cvtpk(a[0], a[1]), cvtpk(a[2], a[3]), cvtpk(b[0], b[1]), cvtpk(b[2], b[3])};
    return *reinterpret_cast<bf16x8*>(&w);
}
template <class T> __device__ __forceinline__ bf16x8 load8(const T* p) {
    if constexpr (same_t<T, float>::v) { return pack8(*(const f32x4*)p, *(const f32x4*)(p + 4)); }
    else { return *reinterpret_cast<const bf16x8*>(p); }
}
__device__ __forceinline__ void mask_tile(f32x16& p0, f32x16& p1, int dq, unsigned W) {
    const float NEG = -__builtin_inff();
#pragma unroll
    for (int r = 0; r < 16; ++r) {
        const int c = (r & 3) + 8 * (r >> 2);
        if ((unsigned)(dq - c) >= W) p0[r] = NEG;
        if ((unsigned)(dq - c - 32) >= W) p1[r] = NEG;
    }
}
__device__ __forceinline__ void partialSM(f32x16& p0, f32x16& p1, float& m_reg, float& mn, float& alpha) {
    float pmax = p0[0]; for (int r = 1; r < 16; ++r) pmax = fmaxf(pmax, p0[r]); for (int r = 0; r < 16; ++r) pmax = fmaxf(pmax, p1[r]);
    { auto rr = __builtin_amdgcn_permlane32_swap(__float_as_uint(pmax), __float_as_uint(pmax), false, false);
      pmax = fmaxf(__uint_as_float(rr[0]), __uint_as_float(rr[1])); }
    constexpr float C2 = 1.4426950408889634f * SCALE;
    if (__builtin_expect(__all((pmax - m_reg) * SCALE <= THR), 1)) { mn = m_reg; alpha = 1.f; }
    else { mn = fmaxf(m_reg, pmax); alpha = __builtin_amdgcn_exp2f((m_reg - mn) * C2); m_reg = mn; }
    const float mnL = -mn * C2;
    for (int r = 0; r < 16; ++r) p0[r] = fmaf(p0[r], C2, mnL); for (int r = 0; r < 16; ++r) p1[r] = fmaf(p1[r], C2, mnL);
    for (int r = 0; r < 16; ++r) p0[r] = __builtin_amdgcn_exp2f(p0[r]);
}
__device__ __forceinline__ void finishSM(f32x16& p0, f32x16& p1, float alpha, float& l_reg, bf16x8& pa0, bf16x8& pa1, bf16x8& pa2, bf16x8& pa3) {
    for (int r = 0; r < 16; ++r) p1[r] = __builtin_amdgcn_exp2f(p1[r]);
    float ps = 0; for (int r = 0; r < 16; ++r) ps += p0[r]; for (int r = 0; r < 16; ++r) ps += p1[r];
    { auto rr = __builtin_amdgcn_permlane32_swap(__float_as_uint(ps), __float_as_uint(ps), false, false);
      ps = __uint_as_float(rr[0]) + __uint_as_float(rr[1]); }
    l_reg = l_reg * alpha + ps;
#define PK4(P, B_, OUT) do { unsigned a0 = cvtpk(P[B_+0], P[B_+1]), a1 = cvtpk(P[B_+2], P[B_+3]);                          \
        unsigned b0 = cvtpk(P[B_+4], P[B_+5]), b1 = cvtpk(P[B_+6], P[B_+7]);                                             \
        auto r0 = __builtin_amdgcn_permlane32_swap(a0, b0, false, false); auto r1 = __builtin_amdgcn_permlane32_swap(a1, b1, false, false); \
        u32x4 w = {r0[0], r1[0], r0[1], r1[1]}; OUT = *reinterpret_cast<bf16x8*>(&w); } while (0)
    PK4(p0, 0, pa0); PK4(p0, 8, pa1); PK4(p1, 0, pa2); PK4(p1, 8, pa3);
#undef PK4
}
template <int KB, bool SK>
__device__ __forceinline__ void qkt(f32x16& p0, f32x16& p1, const char* K_lds, int r32, int hi, const bf16x8* qr, bool act) {
    if (SK && !act) { const float NEG = -__builtin_inff();
#pragma unroll
        for (int r = 0; r < 16; ++r) { p0[r] = NEG; p1[r] = NEG; } return; }
    p0 = f32x16{}; p1 = f32x16{};
    const char* kb[4];
#pragma unroll
    for (int dd = 0; dd < 4; ++dd) kb[dd] = K_lds + KB * SHM_K + KSWZ(r32, (dd * 16 + hi * 8) * 2);
#pragma unroll
    for (int d0 = 0; d0 < 8; ++d0) { const char* a = kb[d0 & 3] + (d0 >> 2) * 128;
        bf16x8 b0 = *reinterpret_cast<const bf16x8*>(a);
        bf16x8 b1 = *reinterpret_cast<const bf16x8*>(a + 32 * 256);
        p0 = __builtin_amdgcn_mfma_f32_32x32x16_bf16(b0, qr[d0], p0, 0, 0, 0);
        p1 = __builtin_amdgcn_mfma_f32_32x32x16_bf16(b1, qr[d0], p1, 0, 0, 0); }
}
template <int VB, bool SK>
__device__ __forceinline__ void pv_tile(f32x16* o, int vb0, bf16x8 pa0, bf16x8 pa1, bf16x8 pa2, bf16x8 pa3, bool act) {
    if (SK && !act) return;
#define TRRD(dst, off) asm volatile("ds_read_b64_tr_b16 %0, %1 offset:%2" : "=&v"(dst) : "v"(vb0), "i"(off) : "memory")
#define PV_D0(d0) do { s16x4 l0, l1, l2, l3, h0, h1, h2, h3; constexpr int b_ = VB * SHM_V + v_rd_off(d0, 0, 0);     \
        TRRD(l0, b_); TRRD(h0, b_ + 2048); TRRD(l1, b_ + 4096); TRRD(h1, b_ + 6144); TRRD(l2, b_ + 8192); TRRD(h2, b_ + 10240); TRRD(l3, b_ + 12288); TRRD(h3, b_ + 14336); \
        asm volatile("s_waitcnt lgkmcnt(0)" ::: "memory"); SBAR();                 \
        o[d0] = __builtin_amdgcn_mfma_f32_32x32x16_bf16(pa0, (bf16x8){l0[0], l0[1], l0[2], l0[3], h0[0], h0[1], h0[2], h0[3]}, o[d0], 0, 0, 0);   \
        o[d0] = __builtin_amdgcn_mfma_f32_32x32x16_bf16(pa1, (bf16x8){l1[0], l1[1], l1[2], l1[3], h1[0], h1[1], h1[2], h1[3]}, o[d0], 0, 0, 0);   \
        o[d0] = __builtin_amdgcn_mfma_f32_32x32x16_bf16(pa2, (bf16x8){l2[0], l2[1], l2[2], l2[3], h2[0], h2[1], h2[2], h2[3]}, o[d0], 0, 0, 0);   \
        o[d0] = __builtin_amdgcn_mfma_f32_32x32x16_bf16(pa3, (bf16x8){l3[0], l3[1], l3[2], l3[3], h3[0], h3[1], h3[2], h3[3]}, o[d0], 0, 0, 0); } while (0)
    PV_D0(0); PV_D0(1); PV_D0(2); PV_D0(3);
#undef PV_D0
#undef TRRD
}

template <class TIn, class TOut> struct BlockRef { const TIn* Q; const TIn* K; const TIn* V; TOut* O; int P0; };
template <class TIn> struct Seam {
    bf16x8 qr[8];
    bf16x8 st_v0, st_v1, st_k0, st_k1; f32x4 sf0, sf1, sf2, sf3;
    f32x4 tq[16];
};
__device__ __forceinline__ int swa_jlo(int P0, int W) { const int lowk = P0 - W + 1; return lowk > 0 ? lowk / KVBLK : 0; }
#define ROW(p, k0, rr) ((p) + (unsigned)(((k0) + (rr)) * LD + sc))
#define VMW() asm volatile("s_waitcnt vmcnt(0)" ::: "memory")
#define VMWN(n) asm volatile("s_waitcnt vmcnt(%0)" :: "i"(n) : "memory")
#define SLOAD_H(Kp, Vp, k0) do { S.st_v0 = load8<TIn>(ROW(Vp, k0, sr)); S.st_v1 = load8<TIn>(ROW(Vp, k0, 32 + sr));              \
                         S.st_k0 = load8<TIn>(ROW(Kp, k0, sr)); S.st_k1 = load8<TIn>(ROW(Kp, k0, 32 + sr)); } while (0)
#define SWRITE_HK(bf) do { *(bf16x8*)(K_lds + (bf) * SHM_K + kws) = S.st_k0; *(bf16x8*)(K_lds + (bf) * SHM_K + kws + 32 * 256) = S.st_k1; } while (0)
#define SWRITE_HV(bf) do { *(bf16x8*)(V_lds + (bf) * SHM_V + vst0) = S.st_v0; *(bf16x8*)(V_lds + (bf) * SHM_V + vst1) = S.st_v1; } while (0)
#define SWRITE_H(bf) do { SWRITE_HV(bf); SWRITE_HK(bf); } while (0)
#define SLOAD_F(p, k0) do { S.sf0 = *(const f32x4*)ROW(p, k0, sr); S.sf1 = *(const f32x4*)(ROW(p, k0, sr) + 4);                \
                            S.sf2 = *(const f32x4*)ROW(p, k0, 32 + sr); S.sf3 = *(const f32x4*)(ROW(p, k0, 32 + sr) + 4); } while (0)
#define SWRITE_KF(bf) do { *(bf16x8*)(K_lds + (bf) * SHM_K + kws) = pack8(S.sf0, S.sf1); *(bf16x8*)(K_lds + (bf) * SHM_K + kws + 32 * 256) = pack8(S.sf2, S.sf3); } while (0)
#define SWRITE_VF(bf) do { *(bf16x8*)(V_lds + (bf) * SHM_V + vst0) = pack8(S.sf0, S.sf1); *(bf16x8*)(V_lds + (bf) * SHM_V + vst1) = pack8(S.sf2, S.sf3); } while (0)
template <class TIn, class TOut>
__device__ __forceinline__ void causal_swa_prime(const BlockRef<TIn, TOut>& cur, int W, char* lds, Seam<TIn>& S, const int wv) {
    constexpr bool F32 = same_t<TIn, float>::v;
    const int tid = tid_of(wv), wid = __builtin_amdgcn_readfirstlane(tid >> 6), lane = tid & 63, r32 = lane & 31, hi = lane >> 5;
    const int sr = tid >> 4, sc = (tid & 15) * 8, kws = KSWZ(sr, sc * 2); char* K_lds = lds + 2 * SHM_V;
    const int kb0 = swa_jlo(cur.P0, W) * KVBLK;
    for (int d0 = 0; d0 < 8; ++d0) S.qr[d0] = load8<TIn>(cur.Q + (unsigned)((wid * QBLK + r32) * LD + d0 * 16 + hi * 8));
    if constexpr (F32) { SLOAD_F((const float*)cur.K, kb0); VMW(); SWRITE_KF(0); SBAR(); SLOAD_F((const float*)cur.V, kb0); }
    else { SLOAD_H(cur.K, cur.V, kb0); VMW(); SWRITE_HK(0); }
    __syncthreads();
}
template <class TIn, class TOut>
__device__ __forceinline__ void causal_swa_block(const BlockRef<TIn, TOut>& cur, const BlockRef<TIn, TOut>& nxt, int skv, int W, char* lds, Seam<TIn>& S, const __attribute__((address_space(3))) unsigned char* rowmask, const int wv) {
    constexpr bool F32 = same_t<TIn, float>::v;
    const int tid = tid_of(wv), wid = __builtin_amdgcn_readfirstlane(tid >> 6), lane = tid & 63, r32 = lane & 31, hi = lane >> 5;
    const int j_lo = swa_jlo(cur.P0, W);
    int j_hi = (cur.P0 + QB - 1) / KVBLK + 1; if (j_hi > skv / KVBLK) j_hi = skv / KVBLK;
    const int NT = j_hi - j_lo;
    const int kbn = swa_jlo(nxt.P0, W) * KVBLK;
    const int qlo = cur.P0 + wid * QBLK, qm = qlo + r32 - 4 * hi;
    char* V_lds = lds; char* K_lds = lds + 2 * SHM_V;
    float* ws = (float*)(lds + 2 * SHM_V + 2 * SHM_K) + wid * 64; float* li_l = ws, * al_l = ws + 32;
    float m_reg = -1e30f, l_reg = 0; f32x16 o[4] = {};
    const int sr = tid >> 4, sc = (tid & 15) * 8, vst0 = v_st(sr, sc), vst1 = v_st(32 + sr, sc), kws = KSWZ(sr, sc * 2);
    const int vb0 = (int)(uintptr_t)V_lds + v_rd_base(lane);
    const TIn* Kh = cur.K; const TIn* Vh = cur.V;
#define RESC(a) do { if (__any((a) < 1.f)) { if (hi == 0) al_l[r32] = (a); asm volatile("s_waitcnt lgkmcnt(0)" ::: "memory");              \
                     for (int d_ = 0; d_ < 4; ++d_) for (int r = 0; r < 16; ++r) o[d_][r] *= al_l[crow(r, hi)]; } } while (0)
#define KBASE(t) ((j_lo + (t)) * KVBLK)
#define ACT(t) (KBASE(t) <= qlo + QBLK - 1 && KBASE(t) + KVBLK - 1 >= qlo - W + 1)
#define MASKT(P0_, P1_, t) do { const int kb_ = KBASE(t); \
        if (kb_ < cur.P0) { const bool keep_ = (((unsigned)rowmask[wid * QBLK + r32] >> (kb_ >> 8)) & 1u) != 0u; if (!__all(keep_)) { const float NEG_ = -__builtin_inff(); \
            _Pragma("unroll") for (int r_ = 0; r_ < 16; ++r_) { P0_[r_] = keep_ ? P0_[r_] : NEG_; P1_[r_] = keep_ ? P1_[r_] : NEG_; } } } \
        else if (kb_ + KVBLK - 1 > qlo) mask_tile(P0_, P1_, qm - kb_, (unsigned)W); } while (0)
    constexpr int NQL = F32 ? 16 : 8;
    constexpr bool SK = WSKIP && !F32;
#define SEAM_K0() do { VMWN(NQL); if constexpr (F32) { SWRITE_KF(0); SBAR(); SLOAD_F((const float*)nxt.V, kbn); } else { SWRITE_HK(0); } SBAR(); } while (0)
    f32x16 pA0, pA1, pB0, pB1; float mnA, mnB, alA, alB; bf16x8 pa0, pa1, pa2, pa3;
    if constexpr (F32) { VMW(); SWRITE_VF(0); SBAR(); } else { SWRITE_HV(0); SBAR(); }
    if (NT > 1) { if constexpr (F32) SLOAD_F((const float*)Kh, KBASE(1)); else SLOAD_H(Kh, Vh, KBASE(1)); }
    SBAR(); qkt<0, SK>(pA0, pA1, K_lds, r32, hi, S.qr, ACT(0));
    if constexpr (F32) { if (NT > 1) { VMW(); SWRITE_KF(1); SBAR(); SLOAD_F((const float*)Vh, KBASE(1)); } }
    MASKT(pA0, pA1, 0); partialSM(pA0, pA1, m_reg, mnA, alA);
    if (NT > 1) { VMW(); if constexpr (F32) { SWRITE_VF(1); SBAR(); if (NT > 2) SLOAD_F((const float*)Kh, KBASE(2)); } else SWRITE_H(1); }
    __syncthreads();
#define HALF_STEP(PX0, PX1, mnX, alX, PY0, PY1, alY, t, KB, VB, SB) do {                                                      \
        SBAR(); qkt<KB, SK>(PX0, PX1, K_lds, r32, hi, S.qr, ACT(t));                                             \
        finishSM(PY0, PY1, alY, l_reg, pa0, pa1, pa2, pa3); SBAR();                                                           \
        if ((t) + 1 < NT) { if constexpr (F32) { VMW(); SWRITE_KF(SB); SBAR(); SLOAD_F((const float*)Vh, KBASE((t) + 1)); }  \
                            else { SLOAD_H(Kh, Vh, KBASE((t) + 1)); } SBAR(); }                                               \
        pv_tile<VB, SK>(o, vb0, pa0, pa1, pa2, pa3, ACT((t) - 1)); MASKT(PX0, PX1, (t)); partialSM(PX0, PX1, m_reg, mnX, alX);                                        \
        __syncthreads();                                                                                                      \
        if ((t) + 1 < NT) { VMW(); if constexpr (F32) { SWRITE_VF(SB); SBAR(); if ((t) + 2 < NT) SLOAD_F((const float*)Kh, KBASE((t) + 2)); } \
                            else { SWRITE_H(SB); } }                                                                          \
        RESC(alX); __syncthreads(); } while (0)
    for (int t = 1; t + 1 < NT; t += 2) {
        HALF_STEP(pB0, pB1, mnB, alB, pA0, pA1, alA, t, 1, 0, 0);
        HALF_STEP(pA0, pA1, mnA, alA, pB0, pB1, alB, t + 1, 0, 1, 1);
    }
    const bool even = (NT & 1) == 0;
    if (even) { SBAR(); qkt<1, SK>(pB0, pB1, K_lds, r32, hi, S.qr, ACT(NT - 1)); SBAR(); }
#define QROW(e) (nxt.Q + (size_t)(wid * QBLK + r32) * LD + ((e) >> 1) * 16 + hi * 8 + ((e) & 1) * 4)
    if constexpr (F32) { SLOAD_F((const float*)nxt.K, kbn); SBAR();
#pragma unroll
        for (int e = 0; e < 8; ++e) S.tq[e] = *(const f32x4*)QROW(e); }
    else { SLOAD_H(nxt.K, nxt.V, kbn); SBAR();
#pragma unroll
        for (int d0 = 0; d0 < 8; ++d0) S.qr[d0] = load8<TIn>(nxt.Q + (unsigned)((wid * QBLK + r32) * LD + d0 * 16 + hi * 8)); }
    SBAR();
    finishSM(pA0, pA1, alA, l_reg, pa0, pa1, pa2, pa3); SBAR();
    if constexpr (F32) {
#pragma unroll
        for (int e = 8; e < 16; ++e) S.tq[e] = *(const f32x4*)QROW(e); SBAR(); }
#undef QROW
    pv_tile<0, SK>(o, vb0, pa0, pa1, pa2, pa3, ACT(even ? NT - 2 : NT - 1));
    if (even) { MASKT(pB0, pB1, NT - 1); partialSM(pB0, pB1, m_reg, mnB, alB); __syncthreads(); RESC(alB);
        finishSM(pB0, pB1, alB, l_reg, pa0, pa1, pa2, pa3); SBAR(); pv_tile<1, SK>(o, vb0, pa0, pa1, pa2, pa3, ACT(NT - 1)); }
    SBAR(); SEAM_K0();
    if (hi == 0) li_l[r32] = l_reg; asm volatile("s_waitcnt lgkmcnt(0)" ::: "memory");
    float rli[16];
#pragma unroll
    for (int r = 0; r < 16; ++r) rli[r] = __builtin_amdgcn_rcpf(li_l[crow(r, hi)]);
    TOut* Ow = cur.O + (size_t)(wid * QBLK) * LD;
#pragma unroll
    for (int r = 0; r < 16; ++r) { const int orow = crow(r, hi);
#pragma unroll
        for (int d0 = 0; d0 < 4; ++d0) { const float v = o[d0][r] * rli[r];
            if constexpr (same_t<TOut, float>::v) { Ow[(size_t)orow * LD + d0 * 32 + r32] = v; }
            else { const float vn = __shfl_xor(v, 1);
                   if ((r32 & 1) == 0) *(unsigned*)(Ow + (unsigned)(orow * LD + d0 * 32 + r32)) = cvtpk(v, vn); } } }
    if constexpr (F32) {
#pragma unroll
        for (int d0 = 0; d0 < 8; ++d0) S.qr[d0] = pack8(S.tq[2 * d0], S.tq[2 * d0 + 1]); }
    __syncthreads();
#undef RESC
#undef KBASE
#undef ACT
#undef MASKT
#undef SEAM_K0
#undef HALF_STEP
}
#undef ROW
#undef VMW
#undef VMWN
#undef SLOAD_H
#undef SWRITE_HK
#undef SWRITE_HV
#undef SWRITE_H
#undef SLOAD_F
#undef SWRITE_KF
#undef SWRITE_VF

}

constexpr int NB = 4, SEQ = 2048, DM = 4096, M = NB * SEQ;
constexpr int NH = 16, HD = 128, AW = 2048, LW = 2048, FF = 11008, INC = 18432;
constexpr int MOBA_BLK = 256, MOBA_TOPK = 3;
constexpr float EPS = 1e-6f;

constexpr size_t MiB = 1u << 20;
constexpr size_t WS_CTL = 0, CTL_ZERO_BYTES = 1 * MiB;
constexpr size_t WS_ROPE = 1 * MiB;
constexpr size_t WS_KM = 2 * MiB;
constexpr size_t WS_SP = 2 * MiB + 512 * 1024;
constexpr size_t WS_RS = 2 * MiB + 512 * 1024 + 64 * 1024;
constexpr size_t WS_WGU1 = 8 * MiB;
constexpr size_t WS_WD1 = WS_WGU1 + 172 * MiB;
constexpr size_t WS_WIN = WS_WD1 + 86 * MiB;
constexpr size_t WS_WAO = WS_WIN + 144 * MiB;
constexpr size_t WS_WRO = WS_WAO + 16 * MiB;
constexpr size_t WS_WO = WS_WRO + 16 * MiB;
constexpr size_t WS_WGU2 = WS_WO + 32 * MiB;
constexpr size_t WS_WD2 = WS_WGU2 + 172 * MiB;
constexpr size_t WS_ACT = WS_WD2 + 86 * MiB;
constexpr size_t WS_H = WS_ACT + 64 * MiB;
constexpr size_t WS_F = WS_H + 172 * MiB;
constexpr size_t WS_XR = WS_F + 128 * MiB;
constexpr size_t WS_MG = WS_XR + 128 * MiB;
constexpr size_t WS_END = WS_MG + 64 * MiB;
static_assert(WS_END <= 1500 * MiB, "workspace map");
constexpr int CW_BAR = 4096;

constexpr int RING_OFF = 0, RING_BYTES = 131072;
constexpr int MISC_OFF = RING_BYTES;
constexpr int LDS_BYTES = 147456;
constexpr int NWAVES = 8, NTHR = 512;

#define GAS __attribute__((address_space(1)))
#define LAS __attribute__((address_space(3)))
typedef unsigned short bf16;
typedef unsigned v4u __attribute__((ext_vector_type(4)));
typedef unsigned v2u __attribute__((ext_vector_type(2)));
typedef float f32x4 __attribute__((ext_vector_type(4)));
typedef float f32x2 __attribute__((ext_vector_type(2)));
#define LDS_WAIT() asm volatile("s_waitcnt lgkmcnt(0)" ::: "memory")
#define VM_WAIT() asm volatile("s_waitcnt vmcnt(0)" ::: "memory")
__device__ __forceinline__ unsigned f2bf(float f) { unsigned u = __builtin_bit_cast(unsigned, f); return (u + 0x7fffu + ((u >> 16) & 1u)) >> 16; }
__device__ __forceinline__ unsigned pk2(float lo, float hi) { return f2bf(lo) | (f2bf(hi) << 16); }
__device__ __forceinline__ float bflo(unsigned w) { return __builtin_bit_cast(float, w << 16); }
__device__ __forceinline__ float bfhi(unsigned w) { return __builtin_bit_cast(float, w & 0xffff0000u); }
__device__ __forceinline__ float sigmoidf_(float x) { return __builtin_amdgcn_rcpf(1.f + __expf(-x)); }
__device__ __forceinline__ float gelu_tanh(float x) { const float z = 1.5957691216057308f * (x + 0.044715f * x * x * x); return x * sigmoidf_(z); }
__device__ __forceinline__ float one_minus_exp(float x) {
    const float p = -x * (1.f + x * (0.5f + x * (0.16666667f + x * (0.041666668f + x * (0.0083333338f + x * 0.0013888889f)))));
    return x > -0.3f ? p : 1.f - __expf(x);
}
__device__ __forceinline__ float wave_sum(float v) {
#pragma unroll
    for (int o = 1; o < 64; o <<= 1) v += __shfl_xor(v, o);
    return v;
}
__device__ __forceinline__ float wave_max(float v) {
#pragma unroll
    for (int o = 1; o < 64; o <<= 1) v = fmaxf(v, __shfl_xor(v, o));
    return v;
}

#define XB_TMO      128
#define XB_XCNT(j)  (256  + 64 * (j))
#define XB_XSUB(j)  (1280 + 64 * (j))
#define XB_XGEN(j)  (2304 + 64 * (j))
#define XB_TOP      3328
#define XB_TOPGEN   3392
#define XCD_BAR_WORDS 3456
#define XB_SPIN_CAP (1u << 18)
__device__ __forceinline__ unsigned xb_ld(unsigned* p)              { return __hip_atomic_load(p, __ATOMIC_RELAXED, __HIP_MEMORY_SCOPE_AGENT); }
__device__ __forceinline__ unsigned xb_add(unsigned* p, unsigned v) { return __hip_atomic_fetch_add(p, v, __ATOMIC_RELAXED, __HIP_MEMORY_SCOPE_AGENT); }
__device__ __forceinline__ unsigned xb_xcc_id() { return (unsigned)__builtin_amdgcn_s_getreg((3 << 11) | 20) & 0xFu; }
#define XB_SPIN(cond, bar) do { unsigned _sp = 0; while (cond) { __builtin_amdgcn_s_sleep(1); \
    if ((++_sp & 255u) == 0u) { if (xb_ld(&(bar)[XB_TMO])) break; if (_sp > XB_SPIN_CAP) { atomicAdd(&(bar)[XB_TMO], 1u); break; } } } } while (0)
struct XcdBarrier { unsigned* bar; unsigned x; volatile LAS unsigned* st; int wv; };
__device__ __forceinline__ XcdBarrier xcd_barrier_post(unsigned* bar, volatile LAS unsigned* st, int wv) {
    XcdBarrier b; b.bar = bar; b.x = xb_xcc_id(); b.st = st; b.wv = wv;
    if (tid_of(wv) == 0) (void)xb_add(&bar[XB_XCNT(b.x)], 1u);
    return b;
}
__device__ __forceinline__ void xcd_barrier_complete(unsigned* bar, unsigned x, unsigned& nloc, unsigned& nx) {
    const unsigned G = gridDim.x * gridDim.y * gridDim.z;
    unsigned sum, cnt, mine, sp = 0u;
    for (;;) {
        sum = 0u; cnt = 0u; mine = 0u;
#pragma unroll
        for (unsigned j = 0; j < 16; ++j) { const unsigned c = xb_ld(&bar[XB_XCNT(j)]); sum += c; cnt += (c > 0u) ? 1u : 0u; mine = (j == x) ? c : mine; }
        if (sum == G) break;
        __builtin_amdgcn_s_sleep(1);
        if ((++sp & 255u) == 0u) { if (xb_ld(&bar[XB_TMO])) break; if (sp > XB_SPIN_CAP) { atomicAdd(&bar[XB_TMO], 1u); break; } }
    }
    nloc = mine > 0u ? mine : 1u; nx = cnt > 0u ? cnt : 1u;
}
__device__ __forceinline__ void xcd_barrier(const XcdBarrier& b) {
    asm volatile("s_waitcnt vmcnt(0)" ::: "memory");
    __syncthreads();
    if (tid_of(b.wv) == 0) {
        unsigned* bar = b.bar;
        __builtin_amdgcn_s_waitcnt(0);
        unsigned nloc = b.st[0], nx = b.st[1];
        if (nloc == 0u) { xcd_barrier_complete(bar, b.x, nloc, nx); b.st[0] = nloc; b.st[1] = nx; }
        const unsigned old = xb_add(&bar[XB_XSUB(b.x)], 1u);
        const unsigned gen = old / nloc;
        if (old + 1u == (gen + 1u) * nloc) {
            __builtin_amdgcn_fence(__ATOMIC_RELEASE, "agent");
            asm volatile("s_waitcnt vmcnt(0)" ::: "memory");
            const unsigned og = xb_add(&bar[XB_TOP], 1u);
            const unsigned tg = og / nx;
            if (og + 1u == (tg + 1u) * nx) xb_add(&bar[XB_TOPGEN], 1u);
            else XB_SPIN(xb_ld(&bar[XB_TOPGEN]) == tg, bar);
            __builtin_amdgcn_fence(__ATOMIC_ACQUIRE, "agent");
            xb_add(&bar[XB_XGEN(b.x)], 1u);
            asm volatile("s_waitcnt vmcnt(0)" ::: "memory");
        } else {
            XB_SPIN(xb_ld(&bar[XB_XGEN(b.x)]) == gen, bar);
            __builtin_amdgcn_fence(__ATOMIC_ACQUIRE, "agent");
            asm volatile("s_waitcnt vmcnt(0)" ::: "memory");
        }
    }
    __syncthreads();
}

using pg8::Unit; using pg8::HALF; using pg8::BM; using pg8::cvt_pk_bf16;
typedef pg8::f32x4 (AccT)[2][2][4][2];

constexpr float WGI_SCALE = 2111.f;
__device__ __forceinline__ unsigned pk4_i8(float a, float b, float c, float d) {
    unsigned w = __builtin_amdgcn_cvt_pk_u8_f32(a + 128.f, 0, 0u); w = __builtin_amdgcn_cvt_pk_u8_f32(b + 128.f, 1, w);
    w = __builtin_amdgcn_cvt_pk_u8_f32(c + 128.f, 2, w); w = __builtin_amdgcn_cvt_pk_u8_f32(d + 128.f, 3, w); return w ^ 0x80808080u; }
constexpr int F8T = 48;
constexpr float X8_SCALE = 32.f, WG8_SCALE = 64.f;
constexpr float H8_SCALE = 8.f, W8_SCALE = 128.f;
__device__ __forceinline__ unsigned pk4_fp8(float a, float b, float c, float d) {
    int w = __builtin_amdgcn_cvt_pk_fp8_f32(a, b, 0, false); w = __builtin_amdgcn_cvt_pk_fp8_f32(c, d, w, true); return (unsigned)w; }
constexpr float HQ_SCALE = 127.f / (5.f * 5.656854f * 0.6f);
constexpr float WQ_SCALE = 127.f / (3.85f * 5.656854f * 0.0095311f);
constexpr float DQ_SCALE = 1.f / (HQ_SCALE * WQ_SCALE * 32.f);
template <int HF, bool RSV = true, bool IACC = false>
struct EpiSwiGLU {
    static constexpr bool PERM = true, HAS_RS = RSV;
    bf16* H; const float* RSc; float sc;
    __device__ __forceinline__ void load_rs(const Unit& u, int wr, int fr, float (&rsv)[8]) const {
#pragma unroll
        for (int i = 0; i < 8; ++i) rsv[i] = RSc[u.pm * BM + wr * 64 + fr + (i >> 2) * HALF + (i & 3) * 16] * sc; }
    __device__ __forceinline__ void operator()(AccT& acc, const Unit& u, int wr, int wc, int fr, int fq) const {
        const float rsc[8] = {sc, sc, sc, sc, sc, sc, sc, sc}; (*this)(acc, u, wr, wc, fr, fq, rsc); }
    __device__ __forceinline__ void operator()(AccT& acc, const Unit& u, int wr, int wc, int fr, int fq, const float (&rsv)[8]) const {
        const int row0 = u.pm * BM + wr * 64 + fr, col0 = u.pn * HALF + wc * 32 + 8 * fq;
#pragma unroll
        for (int ai = 0; ai < 2; ++ai)
#pragma unroll
            for (int m = 0; m < 4; ++m) {
                float o[8]; const float rs = rsv[ai * 4 + m];
                if constexpr (HF == 2) {
                    typedef float f2 __attribute__((ext_vector_type(2)));
                    f2 p[4]; const float rsq = rs * HQ_SCALE;
#pragma unroll
                    for (int n = 0; n < 2; ++n)
#pragma unroll
                        for (int h = 0; h < 2; ++h) { const float g0 = acc[ai][0][m][n][2 * h], g1 = acc[ai][0][m][n][2 * h + 1], u0 = acc[ai][1][m][n][2 * h], u1 = acc[ai][1][m][n][2 * h + 1];
                            const f2 gi = IACC ? (f2){(float)__float_as_int(g0), (float)__float_as_int(g1)} : (f2){g0, g1}, ui = IACC ? (f2){(float)__float_as_int(u0), (float)__float_as_int(u1)} : (f2){u0, u1};
                            const f2 gt = gi * rs, up = ui * rsq, ex = gt * -1.4426950408889634f;
                            const f2 den = (f2){__builtin_amdgcn_exp2f(ex.x), __builtin_amdgcn_exp2f(ex.y)} + 1.f;
                            const f2 sg = (f2){__builtin_amdgcn_rcpf(den.x), __builtin_amdgcn_rcpf(den.y)};
                            p[2 * n + h] = gt * sg * up; }
#pragma unroll
                    for (int i = 0; i < 4; ++i) p[i] = (f2){p[i].x + p[i].y, p[i].x - p[i].y};
                    { const f2 t0 = p[0], t2 = p[2]; p[0] = t0 + p[1]; p[1] = t0 - p[1]; p[2] = t2 + p[3]; p[3] = t2 - p[3]; }
                    { const f2 t0 = p[0], t1 = p[1]; p[0] = t0 + p[2]; p[2] = t0 - p[2]; p[1] = t1 + p[3]; p[3] = t1 - p[3]; }
                    { const float s16 = (fq & 1) ? -1.f : 1.f, s32 = (fq & 2) ? -1.f : 1.f;
#pragma unroll
                      for (int i = 0; i < 4; ++i) { const auto r0 = __builtin_amdgcn_permlane16_swap(__float_as_uint(p[i].x), __float_as_uint(p[i].x), false, false), r1 = __builtin_amdgcn_permlane16_swap(__float_as_uint(p[i].y), __float_as_uint(p[i].y), false, false);
                          p[i] = (f2){__uint_as_float(r0[0]), __uint_as_float(r1[0])} + (f2){__uint_as_float(r0[1]), __uint_as_float(r1[1])} * s16; }
#pragma unroll
                      for (int i = 0; i < 4; ++i) { const auto r0 = __builtin_amdgcn_permlane32_swap(__float_as_uint(p[i].x), __float_as_uint(p[i].x), false, false), r1 = __builtin_amdgcn_permlane32_swap(__float_as_uint(p[i].y), __float_as_uint(p[i].y), false, false);
                          p[i] = (f2){__uint_as_float(r0[0]), __uint_as_float(r1[0])} + (f2){__uint_as_float(r0[1]), __uint_as_float(r1[1])} * s32; } }
                    v2u w; w.x = pk4_i8(p[0].x, p[0].y, p[1].x, p[1].y); w.y = pk4_i8(p[2].x, p[2].y, p[3].x, p[3].y);
                    *(v2u*)((unsigned char*)H + (size_t)(row0 + ai * HALF + m * 16) * FF + col0) = w;
                    continue; }
#pragma unroll
                for (int n = 0; n < 2; ++n)
#pragma unroll
                    for (int j = 0; j < 4; ++j) { const float gf = acc[ai][0][m][n][j], uf = acc[ai][1][m][n][j];
                        const float ga = IACC ? (float)__float_as_int(gf) : gf, ua = IACC ? (float)__float_as_int(uf) : uf;
                        const float gt = ga * rs, up = ua * rs; o[4 * n + j] = gt * sigmoidf_(gt) * up; }
                if constexpr (HF == 2) {
#define HAD_BF(a, b) do { const float t_ = a; a = t_ + b; b = t_ - b; } while (0)
                    HAD_BF(o[0], o[1]); HAD_BF(o[2], o[3]); HAD_BF(o[4], o[5]); HAD_BF(o[6], o[7]);
                    HAD_BF(o[0], o[2]); HAD_BF(o[1], o[3]); HAD_BF(o[4], o[6]); HAD_BF(o[5], o[7]);
                    HAD_BF(o[0], o[4]); HAD_BF(o[1], o[5]); HAD_BF(o[2], o[6]); HAD_BF(o[3], o[7]);
#undef HAD_BF
                    { const float s16 = (fq & 1) ? -1.f : 1.f, s32 = (fq & 2) ? -1.f : 1.f;
#pragma unroll
                      for (int e = 0; e < 8; ++e) { const auto r = __builtin_amdgcn_permlane16_swap(__float_as_uint(o[e]), __float_as_uint(o[e]), false, false); o[e] = __uint_as_float(r[0]) + s16 * __uint_as_float(r[1]); }
#pragma unroll
                      for (int e = 0; e < 8; ++e) { const auto r = __builtin_amdgcn_permlane32_swap(__float_as_uint(o[e]), __float_as_uint(o[e]), false, false); o[e] = __uint_as_float(r[0]) + s32 * __uint_as_float(r[1]); } }
                    v2u w; w.x = pk4_i8(o[0] * HQ_SCALE, o[1] * HQ_SCALE, o[2] * HQ_SCALE, o[3] * HQ_SCALE); w.y = pk4_i8(o[4] * HQ_SCALE, o[5] * HQ_SCALE, o[6] * HQ_SCALE, o[7] * HQ_SCALE);
                    *(v2u*)((unsigned char*)H + (size_t)(row0 + ai * HALF + m * 16) * FF + col0) = w;
                } else if constexpr (HF == 1) {
#pragma unroll
                    for (int e = 0; e < 8; ++e) o[e] = __builtin_amdgcn_fmed3f(o[e] * H8_SCALE, -448.f, 448.f);
                    v2u w; w.x = pk4_fp8(o[0], o[1], o[2], o[3]); w.y = pk4_fp8(o[4], o[5], o[6], o[7]);
                    *(v2u*)((unsigned char*)H + (size_t)(row0 + ai * HALF + m * 16) * FF + col0) = w;
                } else {
                    v4u w; w.x = cvt_pk_bf16(o[0], o[1]); w.y = cvt_pk_bf16(o[2], o[3]); w.z = cvt_pk_bf16(o[4], o[5]); w.w = cvt_pk_bf16(o[6], o[7]);
                    *(v4u*)(H + (size_t)(row0 + ai * HALF + m * 16) * FF + col0) = w; }
            }
    }
};
struct EpiF32 {
    static constexpr bool PERM = false, HAS_RS = false;
    bf16* C; int ldc; float sc;
    __device__ __forceinline__ void operator()(AccT& acc, const Unit& u, int wr, int wc, int fr, int fq) const {
        const int row0 = u.pm * BM + wr * 64 + fr, col0 = u.pn * BM + wc * 32 + 4 * fq;
#pragma unroll
        for (int ai = 0; ai < 2; ++ai)
#pragma unroll
            for (int m = 0; m < 4; ++m) { bf16* rowp = C + (size_t)(row0 + ai * HALF + m * 16) * ldc + col0;
#pragma unroll
                for (int bj = 0; bj < 2; ++bj)
#pragma unroll
                    for (int n = 0; n < 2; ++n) { const pg8::f32x4 a = acc[ai][bj][m][n] * sc; v2u w; w.x = cvt_pk_bf16(a[0], a[1]); w.y = cvt_pk_bf16(a[2], a[3]); *(v2u*)(rowp + bj * HALF + n * 16) = w; } }
    }
};
struct EpiF32I {
    static constexpr bool PERM = false, HAS_RS = false;
    bf16* C; int ldc; float sc;
    __device__ __forceinline__ void operator()(AccT& acc, const Unit& u, int wr, int wc, int fr, int fq) const {
        const int row0 = u.pm * BM + wr * 64 + fr, col0 = u.pn * BM + wc * 32 + 4 * fq;
#pragma unroll
        for (int ai = 0; ai < 2; ++ai)
#pragma unroll
            for (int m = 0; m < 4; ++m) { bf16* rowp = C + (size_t)(row0 + ai * HALF + m * 16) * ldc + col0;
#pragma unroll
                for (int bj = 0; bj < 2; ++bj)
#pragma unroll
                    for (int n = 0; n < 2; ++n) { const pg8::f32x4 a = acc[ai][bj][m][n]; const float a0 = a[0], a1 = a[1], a2 = a[2], a3 = a[3];
                        const pg8::f32x4 f = (pg8::f32x4){(float)__float_as_int(a0), (float)__float_as_int(a1), (float)__float_as_int(a2), (float)__float_as_int(a3)} * sc;
                        v2u w; w.x = cvt_pk_bf16(f[0], f[1]); w.y = cvt_pk_bf16(f[2], f[3]);
                        *(v2u*)(rowp + bj * HALF + n * 16) = w; } }
    }
};
struct EpiProj {
    static constexpr bool PERM = true, HAS_RS = true;
    bf16* QKVX; bf16* SAB; const float* CS; const float* SN; float* KM; const float* RSc;
    __device__ __forceinline__ void store8(bf16* p, const float (&o)[8]) const {
        v4u w; w.x = cvt_pk_bf16(o[0], o[1]); w.y = cvt_pk_bf16(o[2], o[3]); w.z = cvt_pk_bf16(o[4], o[5]); w.w = cvt_pk_bf16(o[6], o[7]); *(v4u*)p = w; }
    __device__ __forceinline__ void load_rs(const Unit& u, int wr, int fr, float (&rsv)[8]) const {
#pragma unroll
        for (int i = 0; i < 8; ++i) rsv[i] = RSc[u.pm * BM + wr * 64 + fr + (i >> 2) * HALF + (i & 3) * 16]; }
    __device__ __forceinline__ void operator()(AccT& acc, const Unit& u, int wr, int wc, int fr, int fq, const float (&rsv)[8]) const {
        const int row0 = u.pm * BM + wr * 64 + fr, cw = wc * 32 + 8 * fq, pn = u.pn;
#pragma unroll
        for (int ai = 0; ai < 2; ++ai)
#pragma unroll
            for (int m = 0; m < 4; ++m) { const float rs = rsv[ai * 4 + m];
#pragma unroll
                for (int bj = 0; bj < 2; ++bj)
#pragma unroll
                    for (int n = 0; n < 2; ++n) acc[ai][bj][m][n] *= rs; }
        if (pn < 16) {
            bf16* dst = QKVX + (size_t)(pn >> 3) * ((size_t)M * AW); const int pr = pn & 7; const bool isk = pn >= 8;
            f32x4 ks[2][2];
#pragma unroll
            for (int bj = 0; bj < 2; ++bj)
#pragma unroll
                for (int n = 0; n < 2; ++n) ks[bj][n] = (f32x4){0.f, 0.f, 0.f, 0.f};
#pragma unroll
            for (int ai = 0; ai < 2; ++ai) {
                f32x4 csv[4], snv[4];
#pragma unroll
                for (int m = 0; m < 4; ++m) { const int s = (row0 + ai * HALF + m * 16) & (SEQ - 1);
                    csv[m] = *(const f32x4*)(CS + s * 64 + wc * 16 + 4 * fq); snv[m] = *(const f32x4*)(SN + s * 64 + wc * 16 + 4 * fq); }
#pragma unroll
                for (int m = 0; m < 4; ++m) { const int row = row0 + ai * HALF + m * 16; const f32x4 cs = csv[m], sn = snv[m];
#pragma unroll
                    for (int bj = 0; bj < 2; ++bj) { const f32x4 t1 = acc[ai][bj][m][0], t2 = acc[ai][bj][m][1];
                        const f32x4 o1 = t1 * cs - t2 * sn, o2 = t2 * cs + t1 * sn;
                        ks[bj][0] += o1; ks[bj][1] += o2;
                        float o[8] = {o1[0], o1[1], o1[2], o1[3], o2[0], o2[1], o2[2], o2[3]};
                        store8(dst + (size_t)row * AW + (pr * 2 + bj) * HD + cw, o); } }
                asm volatile("" ::: "memory"); }
            if (isk) {
#pragma unroll
                for (int bj = 0; bj < 2; ++bj)
#pragma unroll
                    for (int n = 0; n < 2; ++n) { f32x4 v = ks[bj][n];
#pragma unroll
                        for (int o = 1; o < 16; o <<= 1) { v[0] += __shfl_xor(v[0], o); v[1] += __shfl_xor(v[1], o); v[2] += __shfl_xor(v[2], o); v[3] += __shfl_xor(v[3], o); }
                        if (fr == 0) *(f32x4*)(KM + ((size_t)wr * 32 + u.pm) * AW + (pr * 2 + bj) * HD + cw + 4 * n) = v; }
            }
        } else if (pn < 40) {
            const int t = (pn - 16) >> 3, pr = pn & 7; bf16* dst = QKVX + (size_t)(pn >> 3) * ((size_t)M * AW);
#pragma unroll
            for (int ai = 0; ai < 2; ++ai)
#pragma unroll
                for (int m = 0; m < 4; ++m) { const int row = row0 + ai * HALF + m * 16;
#pragma unroll
                    for (int bj = 0; bj < 2; ++bj) { float o[8];
#pragma unroll
                        for (int n = 0; n < 2; ++n)
#pragma unroll
                            for (int j = 0; j < 4; ++j) { const float x = acc[ai][bj][m][n][j]; o[4 * n + j] = (t == 2) ? gelu_tanh(x) : x; }
                        store8(dst + (size_t)row * AW + pr * BM + bj * HALF + cw, o); } }
        } else {
            const int pr = (pn - 40) & 15; bf16* dst = SAB + (size_t)((pn - 40) >> 4) * ((size_t)M * DM);
#pragma unroll
            for (int ai = 0; ai < 2; ++ai)
#pragma unroll
                for (int m = 0; m < 4; ++m) { const int row = row0 + ai * HALF + m * 16;
#pragma unroll
                    for (int bj = 0; bj < 2; ++bj) { float o[8];
#pragma unroll
                        for (int n = 0; n < 2; ++n)
#pragma unroll
                            for (int j = 0; j < 4; ++j) o[4 * n + j] = sigmoidf_(acc[ai][bj][m][n][j]);
                        store8(dst + (size_t)row * DM + pr * BM + bj * HALF + cw, o); } }
        }
    }
};
constexpr int F1T = 86;
typedef float f2v __attribute__((ext_vector_type(2)));
constexpr int I8A0 = 0, I8A1 = 24, I8B0 = 40;
constexpr int GATE_PN0 = 40;
struct EpiGate {
    static constexpr bool PERM = true, HAS_RS = true;
    bf16* SAB; const float* RSc; float sc; bf16* QKVX;
    __device__ __forceinline__ void load_rs(const Unit& u, int wr, int fr, float (&rsv)[8]) const {
#pragma unroll
        for (int i = 0; i < 8; ++i) rsv[i] = RSc[u.pm * BM + wr * 64 + fr + (i >> 2) * HALF + (i & 3) * 16] * sc; }
    __device__ __forceinline__ void operator()(AccT& acc, const Unit& u, int wr, int wc, int fr, int fq, const float (&rsv)[8]) const {
        const int row0 = u.pm * BM + wr * 64 + fr, cw = wc * 32 + 8 * fq, pn = u.pn;
        if (pn < GATE_PN0) {
            const int t = (pn - 16) >> 3, pr8 = pn & 7; bf16* dq = QKVX + (size_t)(pn >> 3) * ((size_t)M * AW);
#pragma unroll
            for (int ai = 0; ai < 2; ++ai)
#pragma unroll
                for (int m = 0; m < 4; ++m) { const int row = row0 + ai * HALF + m * 16; const float rs = rsv[ai * 4 + m];
#pragma unroll
                    for (int bj = 0; bj < 2; ++bj) { f2v o[4];
#pragma unroll
                        for (int n = 0; n < 2; ++n)
#pragma unroll
                            for (int h = 0; h < 2; ++h) { const float a0 = acc[ai][bj][m][n][2 * h], a1 = acc[ai][bj][m][n][2 * h + 1];
                                const f2v x = (f2v){(float)__float_as_int(a0), (float)__float_as_int(a1)} * rs; o[2 * n + h] = (t == 2) ? (f2v){gelu_tanh(x.x), gelu_tanh(x.y)} : x; }
                        v4u w; w.x = cvt_pk_bf16(o[0].x, o[0].y); w.y = cvt_pk_bf16(o[1].x, o[1].y); w.z = cvt_pk_bf16(o[2].x, o[2].y); w.w = cvt_pk_bf16(o[3].x, o[3].y);
                        *(v4u*)(dq + (size_t)row * AW + pr8 * BM + bj * HALF + cw) = w; } }
            return; }
        const int pr = (pn - GATE_PN0) & 15; bf16* dst = SAB + (size_t)((pn - GATE_PN0) >> 4) * ((size_t)M * DM);
#pragma unroll
        for (int ai = 0; ai < 2; ++ai)
#pragma unroll
            for (int m = 0; m < 4; ++m) { const int row = row0 + ai * HALF + m * 16; const float rs = rsv[ai * 4 + m];
#pragma unroll
                for (int bj = 0; bj < 2; ++bj) { f2v o[4]; const float rsn = rs * -1.4426950408889634f;
#pragma unroll
                    for (int n = 0; n < 2; ++n)
#pragma unroll
                        for (int h = 0; h < 2; ++h) { const float a0 = acc[ai][bj][m][n][2 * h], a1 = acc[ai][bj][m][n][2 * h + 1];
                            const f2v ex = (f2v){(float)__float_as_int(a0), (float)__float_as_int(a1)} * rsn;
                            const f2v den = (f2v){__builtin_amdgcn_exp2f(ex.x), __builtin_amdgcn_exp2f(ex.y)} + 1.f;
                            o[2 * n + h] = (f2v){__builtin_amdgcn_rcpf(den.x), __builtin_amdgcn_rcpf(den.y)}; }
                    v4u w; w.x = cvt_pk_bf16(o[0].x, o[0].y); w.y = cvt_pk_bf16(o[1].x, o[1].y); w.z = cvt_pk_bf16(o[2].x, o[2].y); w.w = cvt_pk_bf16(o[3].x, o[3].y);
                    *(v4u*)(dst + (size_t)row * DM + pr * BM + bj * HALF + cw) = w; } }
    }
};
struct EpiProjI {
    static constexpr bool PERM = true, HAS_RS = true;
    EpiProj P; const float* RSq; float sc;
    __device__ __forceinline__ void load_rs(const Unit& u, int wr, int fr, float (&rsv)[8]) const {
#pragma unroll
        for (int i = 0; i < 8; ++i) rsv[i] = RSq[u.pm * BM + wr * 64 + fr + (i >> 2) * HALF + (i & 3) * 16] * sc; }
    __device__ __forceinline__ void operator()(AccT& acc, const Unit& u, int wr, int wc, int fr, int fq, const float (&rsv)[8]) const {
#pragma unroll
        for (int ai = 0; ai < 2; ++ai)
#pragma unroll
            for (int bj = 0; bj < 2; ++bj)
#pragma unroll
                for (int m = 0; m < 4; ++m)
#pragma unroll
                    for (int n = 0; n < 2; ++n) { const pg8::f32x4 a = acc[ai][bj][m][n]; const float a0 = a[0], a1 = a[1], a2 = a[2], a3 = a[3];
                        acc[ai][bj][m][n] = (pg8::f32x4){(float)__float_as_int(a0), (float)__float_as_int(a1), (float)__float_as_int(a2), (float)__float_as_int(a3)}; }
        P(acc, u, wr, wc, fr, fq, rsv);
    }
};
struct EpiMerge {
    static constexpr bool PERM = true, HAS_RS = false;
    const bf16* SA; const bf16* SB; bf16* MG;
    __device__ __forceinline__ void operator()(AccT& acc, const Unit& u, int wr, int wc, int fr, int fq) const {
        const int row0 = u.pm * BM + wr * 64 + fr, col0 = u.pn * BM + wc * 32 + 8 * fq;
#pragma unroll
        for (int ai = 0; ai < 2; ++ai) {
            const size_t rb = (size_t)(row0 + ai * HALF) * DM + col0;
            v4u bw[4][2];
#pragma unroll
            for (int m = 0; m < 4; ++m)
#pragma unroll
                for (int bj = 0; bj < 2; ++bj) bw[m][bj] = *(const v4u*)(SB + rb + (size_t)m * 16 * DM + bj * HALF);
            if (u.seg == 0) {
                v4u aw[4][2];
#pragma unroll
                for (int m = 0; m < 4; ++m)
#pragma unroll
                    for (int bj = 0; bj < 2; ++bj) aw[m][bj] = *(const v4u*)(SA + rb + (size_t)m * 16 * DM + bj * HALF);
#pragma unroll
                for (int m = 0; m < 4; ++m)
#pragma unroll
                    for (int bj = 0; bj < 2; ++bj) {
                        const v4u b = bw[m][bj], a = aw[m][bj];
                        const float sb[8] = {bflo(b.x), bfhi(b.x), bflo(b.y), bfhi(b.y), bflo(b.z), bfhi(b.z), bflo(b.w), bfhi(b.w)};
                        const float sa[8] = {bflo(a.x), bfhi(a.x), bflo(a.y), bfhi(a.y), bflo(a.z), bfhi(a.z), bflo(a.w), bfhi(a.w)};
#pragma unroll
                        for (int n = 0; n < 2; ++n) { const pg8::f32x4 sav = (pg8::f32x4){sa[4 * n], sa[4 * n + 1], sa[4 * n + 2], sa[4 * n + 3]};
                            const pg8::f32x4 rbv = (pg8::f32x4){__builtin_amdgcn_rcpf(sb[4 * n]), __builtin_amdgcn_rcpf(sb[4 * n + 1]), __builtin_amdgcn_rcpf(sb[4 * n + 2]), __builtin_amdgcn_rcpf(sb[4 * n + 3])};
                            acc[ai][bj][m][n] = acc[ai][bj][m][n] * (sav * rbv); }
                    }
            } else {
#pragma unroll
                for (int m = 0; m < 4; ++m)
#pragma unroll
                    for (int bj = 0; bj < 2; ++bj) {
                        const v4u b = bw[m][bj];
                        const float sb[8] = {bflo(b.x), bfhi(b.x), bflo(b.y), bfhi(b.y), bflo(b.z), bfhi(b.z), bflo(b.w), bfhi(b.w)};
                        const pg8::f32x4 o0 = acc[ai][bj][m][0] * (pg8::f32x4){sb[0], sb[1], sb[2], sb[3]}, o1 = acc[ai][bj][m][1] * (pg8::f32x4){sb[4], sb[5], sb[6], sb[7]};
                        v4u w; w.x = cvt_pk_bf16(o0[0], o0[1]); w.y = cvt_pk_bf16(o0[2], o0[3]); w.z = cvt_pk_bf16(o1[0], o1[1]); w.w = cvt_pk_bf16(o1[2], o1[3]);
                        *(v4u*)(MG + rb + (size_t)m * 16 * DM + bj * HALF) = w;
                    }
            }
            asm volatile("" ::: "memory");
        }
    }
};

struct Args {
    const float* in[24];
    float* out; unsigned char* ws;
    int ph_lo, ph_hi;
};
enum { I_X = 0, I_F1PRE, I_F1G, I_F1U, I_F1D, I_F1POST, I_MIXPRE, I_WIN, I_CONVW, I_CONVB, I_RGWA, I_RGBA, I_RGWX, I_RGBX, I_LAM,
       I_WAO, I_WRO, I_WO, I_MIXPOST, I_F2PRE, I_F2G, I_F2U, I_F2D, I_F2POST };

__device__ __forceinline__ int dest_row(int mode, int c) {
    if (mode == 0) return c;
    if (mode == 1) return (c >> 7) * 256 + (c & 127);
    if (mode == 2) return (c >> 7) * 256 + 128 + (c & 127);
    if (c >= 2 * AW) return c;
    const int d = c & 127, nn = d >> 6, rem = d & 63, wc = rem >> 4, fq = (rem >> 2) & 3, j = rem & 3;
    return (c & ~127) + 32 * wc + 8 * fq + 4 * nn + j;
}
__device__ __forceinline__ void p0_transpose_item(const float* W, int K, int N, bf16* WT, int mode, LAS float* scr, int item, int lane) {
    const int nblk = N / 32, kb = item / nblk, nb = item % nblk, k0 = 64 * kb, n0 = 32 * nb;
#pragma unroll 8
    for (int i = 0; i < 32; ++i) { const int kk = 2 * i + (lane >> 5); scr[kk * 33 + (lane & 31)] = W[(size_t)(k0 + kk) * N + n0 + (lane & 31)]; }
    LDS_WAIT(); asm volatile("" ::: "memory");
    const int c = lane & 7;
#pragma unroll
    for (int j = 0; j < 4; ++j) { const int n = (lane >> 3) + 8 * j; const LAS float* s = scr + (8 * c) * 33 + n;
        v4u o; o.x = pk2(s[0 * 33], s[1 * 33]); o.y = pk2(s[2 * 33], s[3 * 33]); o.z = pk2(s[4 * 33], s[5 * 33]); o.w = pk2(s[6 * 33], s[7 * 33]);
        const int dr = dest_row(mode, n0 + n);
        *(GAS v4u*)(WT + ((size_t)(dr >> 8) * (K >> 6) + kb) * 16384 + (dr & 255) * 64 + 8 * c) = o; }
    LDS_WAIT(); asm volatile("" ::: "memory");
}
__device__ __forceinline__ void p0_transpose_item64(const float* W, int K, int N, bf16* WT, int mode, LAS float* scr_, int item, int lane) {
    LAS unsigned* scr = (LAS unsigned*)scr_;
    const int nblk = N / 64, kb = item / nblk, nb = item % nblk, k0 = 64 * kb, n0 = 64 * nb;
    const int kr = lane >> 4, nq = lane & 15;
    const float* src = W + (size_t)(k0 + 2 * kr) * N + n0 + 4 * nq;
    f32x4 v0[8], v1[8];
#pragma unroll
    for (int p = 0; p < 8; ++p) { v0[p] = *(const f32x4*)(src + (size_t)(8 * p) * N); v1[p] = *(const f32x4*)(src + (size_t)(8 * p + 1) * N); }
#pragma unroll
    for (int p = 0; p < 8; ++p)
#pragma unroll
        for (int j = 0; j < 4; ++j) scr[(4 * nq + j) * 33 + 4 * p + kr] = pg8::cvt_pk_bf16(v0[p][j], v1[p][j]);
    LDS_WAIT(); asm volatile("" ::: "memory");
    const int nr = lane >> 3, c = lane & 7;
#pragma unroll
    for (int q = 0; q < 8; ++q) { const int n = 8 * q + nr; const LAS unsigned* t = scr + n * 33 + 4 * c;
        v4u o; o.x = t[0]; o.y = t[1]; o.z = t[2]; o.w = t[3];
        const int dr = dest_row(mode, n0 + n);
        *(GAS v4u*)(WT + ((size_t)(dr >> 8) * (K >> 6) + kb) * 16384 + (dr & 255) * 64 + 8 * c) = o; }
    LDS_WAIT(); asm volatile("" ::: "memory");
}
__device__ __forceinline__ int invperm32(int x) { return 16 * ((x >> 2) & 1) + 4 * (x >> 3) + (x & 3); }
template <int NBAT>
__device__ __forceinline__ void conv_stream_items(const float* W, int N, bf16* WT, int mode, bool perm, int K, int it, int stride, int nitems, int lane, const float* gain = nullptr, int col0 = 0, int ncb = 0) {
    const int nblk = ncb ? ncb : (N >> 8);
    float v[NBAT][4][8], gk[NBAT][8];
#pragma unroll
    for (int b = 0; b < NBAT; ++b) { const int i = it + b * stride, ic = i < nitems ? i : nitems - 1, kc = ic / nblk, nbk = ic - kc * nblk;
        const float* src = W + (size_t)(8 * kc) * N + col0 + 256 * nbk + lane;
#pragma unroll
        for (int e = 0; e < 8; ++e) gk[b][e] = gain ? gain[8 * kc + e] : 1.f;
#pragma unroll
        for (int j = 0; j < 4; ++j)
#pragma unroll
            for (int e = 0; e < 8; ++e) v[b][j][e] = __builtin_nontemporal_load(src + (size_t)e * N + 64 * j); }
#pragma unroll
    for (int b = 0; b < NBAT; ++b) { const int i = it + b * stride;
        if (i < nitems) { const int kc = i / nblk, nbk = i - kc * nblk;
#pragma unroll
            for (int j = 0; j < 4; ++j) { int r = dest_row(mode, col0 + 256 * nbk + lane + 64 * j); if (perm) r = (r & ~31) + invperm32(r & 31);
                v4u o; o.x = pg8::cvt_pk_bf16(v[b][j][0] * gk[b][0], v[b][j][1] * gk[b][1]); o.y = pg8::cvt_pk_bf16(v[b][j][2] * gk[b][2], v[b][j][3] * gk[b][3]);
                o.z = pg8::cvt_pk_bf16(v[b][j][4] * gk[b][4], v[b][j][5] * gk[b][5]); o.w = pg8::cvt_pk_bf16(v[b][j][6] * gk[b][6], v[b][j][7] * gk[b][7]);
                *(GAS v4u*)(WT + ((((size_t)(r >> 8) * (K >> 6) + (kc >> 3)) * 8 + (kc & 7)) * 256 + (r & 255)) * 8) = o; } } }
}
template <int NBAT>
__device__ __forceinline__ void conv_stream_items8(const float* W, int N, unsigned char* WT, int K, int it, int stride, int nitems, int lane, float wscale, int mode = 0, bool perm = false, const float* gain = nullptr, int ncb = 0, size_t tile_bytes = 0, bool i8 = false, int col0 = 0) {
    const int nblk = ncb ? ncb : (N >> 7); const size_t tb = tile_bytes ? tile_bytes : (size_t)256 * K;
    float v[NBAT][2][16], gk[NBAT][16];
#pragma unroll
    for (int b = 0; b < NBAT; ++b) { const int i = it + b * stride, ic = i < nitems ? i : nitems - 1, kc = ic / nblk, nbk = ic - kc * nblk;
        const float* src = W + (size_t)(16 * kc) * N + col0 + 128 * nbk + lane;
#pragma unroll
        for (int e = 0; e < 16; ++e) gk[b][e] = gain ? gain[16 * kc + e] * wscale : wscale;
#pragma unroll
        for (int j = 0; j < 2; ++j)
#pragma unroll
            for (int e = 0; e < 16; ++e) v[b][j][e] = __builtin_nontemporal_load(src + (size_t)e * N + 64 * j); }
#pragma unroll
    for (int b = 0; b < NBAT; ++b) { const int i = it + b * stride;
        if (i < nitems) { const int kc = i / nblk, nbk = i - kc * nblk;
#pragma unroll
            for (int j = 0; j < 2; ++j) { int r = dest_row(mode, col0 + 128 * nbk + lane + 64 * j); if (perm) r = (r & ~31) + invperm32(r & 31);
                float q[16];
#pragma unroll
                for (int e = 0; e < 16; ++e) q[e] = v[b][j][e] * gk[b][e];
                v4u o;
                if (i8) { o.x = pk4_i8(q[0], q[1], q[2], q[3]); o.y = pk4_i8(q[4], q[5], q[6], q[7]); o.z = pk4_i8(q[8], q[9], q[10], q[11]); o.w = pk4_i8(q[12], q[13], q[14], q[15]); }
                else { o.x = pk4_fp8(q[0], q[1], q[2], q[3]); o.y = pk4_fp8(q[4], q[5], q[6], q[7]); o.z = pk4_fp8(q[8], q[9], q[10], q[11]); o.w = pk4_fp8(q[12], q[13], q[14], q[15]); }
                *(GAS v4u*)(WT + (size_t)(r >> 8) * tb + ((((size_t)(kc >> 3)) * 8 + (kc & 7)) * 256 + (r & 255)) * 16) = o; } } }
}
template <int NBAT>
__device__ __forceinline__ void conv_had_items(const float* W, int N, unsigned char* WT, int K, int it, int stride, int nitems, int lane, float wscale) {
    const int nblk = N >> 6; const size_t tb = (size_t)256 * K;
    float v[NBAT][32];
#pragma unroll
    for (int b = 0; b < NBAT; ++b) { const int i = it + b * stride, ic = i < nitems ? i : nitems - 1, kc = ic / nblk, nbk = ic - kc * nblk;
        const float* src = W + (size_t)(32 * kc) * N + 64 * nbk + lane;
#pragma unroll
        for (int e = 0; e < 32; ++e) v[b][e] = __builtin_nontemporal_load(src + (size_t)e * N); }
#pragma unroll
    for (int b = 0; b < NBAT; ++b) { const int i = it + b * stride;
        if (i < nitems) { const int kc = i / nblk, nbk = i - kc * nblk, r = 64 * nbk + lane;
#pragma unroll
            for (int st = 1; st < 32; st <<= 1)
#pragma unroll
                for (int e = 0; e < 32; ++e) if (!(e & st)) { const float t = v[b][e]; v[b][e] = t + v[b][e + st]; v[b][e + st] = t - v[b][e + st]; }
#pragma unroll
            for (int h = 0; h < 2; ++h) { const int kc16 = 2 * kc + h; v4u o;
                o.x = pk4_i8(v[b][16 * h + 0] * wscale, v[b][16 * h + 1] * wscale, v[b][16 * h + 2] * wscale, v[b][16 * h + 3] * wscale);
                o.y = pk4_i8(v[b][16 * h + 4] * wscale, v[b][16 * h + 5] * wscale, v[b][16 * h + 6] * wscale, v[b][16 * h + 7] * wscale);
                o.z = pk4_i8(v[b][16 * h + 8] * wscale, v[b][16 * h + 9] * wscale, v[b][16 * h + 10] * wscale, v[b][16 * h + 11] * wscale);
                o.w = pk4_i8(v[b][16 * h + 12] * wscale, v[b][16 * h + 13] * wscale, v[b][16 * h + 14] * wscale, v[b][16 * h + 15] * wscale);
                *(GAS v4u*)(WT + (size_t)(r >> 8) * tb + ((((size_t)(kc16 >> 3)) * 8 + (kc16 & 7)) * 256 + (r & 255)) * 16) = o; } } }
}
__device__ __forceinline__ void rms_row_to_bf16(const float* xrow, const float* g, bf16* orow, int lane) {
    const f32x4* xr = (const f32x4*)xrow + lane; const f32x4* gr = (const f32x4*)g + lane;
    f32x4 v[16]; float s = 0.f;
#pragma unroll
    for (int j = 0; j < 16; ++j) { v[j] = xr[64 * j]; s += (v[j].x * v[j].x + v[j].y * v[j].y) + (v[j].z * v[j].z + v[j].w * v[j].w); }
    const float r = 1.f / sqrtf(wave_sum(s) * (1.f / DM) + EPS);
    v2u* o8 = (v2u*)orow + lane;
#pragma unroll
    for (int j = 0; j < 16; ++j) { const f32x4 gg = gr[64 * j]; v2u w; w.x = pk2(v[j].x * r * gg.x, v[j].y * r * gg.y); w.y = pk2(v[j].z * r * gg.z, v[j].w * r * gg.w); o8[64 * j] = w; }
}

template <int TM>
__device__ __forceinline__ void thin_phase(const bf16* FB, const bf16* XB, bf16* XR, float* RSo, float* out, const LAS f32x4* g1, int gw, int NGW, int lane, unsigned char* X8 = nullptr, float* RSq = nullptr) {
    constexpr float SC1 = (TM == 1) ? 1.f : 0.5f;
    const bf16* XS = (TM == 0) ? XB : XR;
    f32x4 va[16], vb[16]; v2u xh[16];
#define TH_LOAD(dst, mm) do { const v2u* fr_ = (const v2u*)(FB + (size_t)(mm) * DM) + lane; \
        _Pragma("unroll") for (int j = 0; j < 16; ++j) { const v2u w_ = fr_[64 * j]; dst[j] = (f32x4){bflo(w_.x), bfhi(w_.x), bflo(w_.y), bfhi(w_.y)}; } \
        { const v2u* xr_ = (const v2u*)(XS + (size_t)(mm) * DM) + lane; _Pragma("unroll") for (int j = 0; j < 16; ++j) xh[j] = xr_[64 * j]; } } while (0)
#define TH_ROW(cur, nxt, mm, mnext) do { float s = 0.f; \
        _Pragma("unroll") for (int j = 0; j < 16; ++j) s += (cur[j].x * cur[j].x + cur[j].y * cur[j].y) + (cur[j].z * cur[j].z + cur[j].w * cur[j].w); \
        const float r1 = SC1 / sqrtf(wave_sum(s) * (1.f / DM) + EPS); float s2 = 0.f, amax = 1e-20f; \
        asm volatile("" ::: "memory"); \
        _Pragma("unroll") for (int j = 0; j < 16; ++j) { const f32x4 xb = (f32x4){bflo(xh[j].x), bfhi(xh[j].x), bflo(xh[j].y), bfhi(xh[j].y)}; \
            cur[j] = xb + cur[j] * r1 * g1[64 * j + lane]; \
            if constexpr (TM == 2) { ((f32x4*)(out + (size_t)(mm) * DM) + lane)[64 * j] = cur[j]; } \
            else { v2u w; w.x = pg8::cvt_pk_bf16(cur[j].x, cur[j].y); w.y = pg8::cvt_pk_bf16(cur[j].z, cur[j].w); ((v2u*)(XR + (size_t)(mm) * DM) + lane)[64 * j] = w; \
                   const f32x4 q = (f32x4){bflo(w.x), bfhi(w.x), bflo(w.y), bfhi(w.y)}; s2 += (q.x * q.x + q.y * q.y) + (q.z * q.z + q.w * q.w); \
                   if constexpr (TM != 2) amax = fmaxf(fmaxf(amax, fmaxf(fabsf(cur[j].x), fabsf(cur[j].y))), fmaxf(fabsf(cur[j].z), fabsf(cur[j].w))); } } \
        asm volatile("" ::: "memory"); \
        if ((mnext) < M) TH_LOAD(nxt, mnext); \
        asm volatile("" ::: "memory"); \
        if constexpr (TM != 2) { const float r2 = 1.f / sqrtf(wave_sum(s2) * (1.f / DM) + EPS); \
            const float am = wave_max(amax), qs = 127.f / am; if (lane == 0) { RSo[mm] = r2; RSq[mm] = am * r2 * (1.f / 127.f); }        \
            _Pragma("unroll") for (int j = 0; j < 16; ++j) ((unsigned*)(X8 + (size_t)(mm) * DM) + lane)[64 * j] = pk4_i8(cur[j].x * qs, cur[j].y * qs, cur[j].z * qs, cur[j].w * qs); } \
        asm volatile("" ::: "memory"); } while (0)
    int m = gw;
    if (m < M) TH_LOAD(va, m);
    while (m < M) {
        int mn = m + NGW;
        TH_ROW(va, vb, m, mn);
        m = mn; if (m >= M) break; mn = m + NGW;
        TH_ROW(vb, va, m, mn);
        m = mn;
    }
#undef TH_LOAD
#undef TH_ROW
}

__global__ void __launch_bounds__(NTHR, 2) fwd(Args args) {
    extern __shared__ __attribute__((aligned(16))) unsigned char lds_raw[];
    LAS unsigned char* lds = (LAS unsigned char*)lds_raw;
    const int G = gridDim.x, bx = blockIdx.x;
    const int WV = __builtin_amdgcn_readfirstlane((int)threadIdx.x >> 6);
    const int vcu = (G % 8 == 0) ? (bx % 8) * (G / 8) + bx / 8 : bx;
    const int NGW = G * NWAVES;
#define PHASE_IDS() int tid = tid_of(WV); asm volatile("" : "+v"(tid)); const int lane = tid & 63, wave = __builtin_amdgcn_readfirstlane(tid >> 6), gw = vcu * NWAVES + wave; (void)lane; (void)gw
    unsigned char* ws = args.ws;
    unsigned* ctl = (unsigned*)(ws + WS_CTL);
    const int lo = args.ph_lo, hi = args.ph_hi;
    if (threadIdx.x < 4) ((LAS unsigned*)(lds + MISC_OFF))[threadIdx.x] = 0u;
    __syncthreads();
    XcdBarrier bar; bar.bar = ctl + CW_BAR; bar.x = 0; bar.st = nullptr; bar.wv = WV;
    if (hi - lo > 1) bar = xcd_barrier_post(ctl + CW_BAR, (volatile LAS unsigned*)(lds + MISC_OFF), WV);
#define IN(k) (lo <= (k) && (k) < hi)
#define SEAM(k) do { if (IN(k) && IN((k) + 1)) xcd_barrier(bar); } while (0)

    const float* x = args.in[I_X];
    bf16* WGU1 = (bf16*)(ws + WS_WGU1); bf16* WD1 = (bf16*)(ws + WS_WD1); bf16* WIN = (bf16*)(ws + WS_WIN);
    bf16* WAO = (bf16*)(ws + WS_WAO); bf16* WRO = (bf16*)(ws + WS_WRO); bf16* WOt = (bf16*)(ws + WS_WO);
    bf16* WGU2 = (bf16*)(ws + WS_WGU2); bf16* WD2 = (bf16*)(ws + WS_WD2);
    bf16* ACT = (bf16*)(ws + WS_ACT); bf16* HB = (bf16*)(ws + WS_H); bf16* FB = (bf16*)(ws + WS_F); bf16* XR = (bf16*)(ws + WS_XR);
    bf16* QB = (bf16*)(ws + WS_H); bf16* KB = QB + (size_t)M * AW; bf16* VB = KB + (size_t)M * AW; bf16* XREC = VB + (size_t)M * AW; bf16* XGATE = XREC + (size_t)M * AW;
    bf16* SAb = (bf16*)(ws + WS_F); bf16* SBb = SAb + (size_t)M * DM;
    bf16* ATT = ACT; bf16* YREC = ACT + (size_t)M * AW;
    bf16* MG = (bf16*)(ws + WS_MG);
    float* RS = (float*)(ws + WS_RS);
    float* CS = (float*)(ws + WS_ROPE); float* SN = CS + SEQ * 64; float* KM = (float*)(ws + WS_KM); float* SPt = (float*)(ws + WS_SP);

    if (IN(0)) {
        PHASE_IDS();
        constexpr int I_GU = (DM / 8) * (FF / 256), I_IN = (DM / 8) * (INC / 256), I_AO = (AW / 8) * (DM / 256), I_OO = (DM / 8) * (DM / 256);
#define CONV_ALL(Wsrc, Ncols, Wdst, mode_, perm_, K_, nit, gain_) for (int it = gw; it < (nit); it += 2 * NGW) conv_stream_items<2>(Wsrc, Ncols, Wdst, mode_, perm_, K_, it, NGW, nit, lane, gain_)
        { constexpr int C8 = 128 * F1T, NCB = (FF - C8) / 256, I_B = (DM / 8) * NCB, I_8 = (DM / 16) * F1T;
          for (int it = gw; it < I_8; it += 2 * NGW) conv_stream_items8<2>(args.in[I_F1G], FF, (unsigned char*)WGU1, DM, it, NGW, I_8, lane, WGI_SCALE, 1, true, args.in[I_F1PRE], F1T, (size_t)512 * DM, true);
          for (int it = gw; it < I_8; it += 2 * NGW) conv_stream_items8<2>(args.in[I_F1U], FF, (unsigned char*)WGU1, DM, it, NGW, I_8, lane, WGI_SCALE, 2, true, args.in[I_F1PRE], F1T, (size_t)512 * DM, true);
          if (NCB > 0) { for (int it = gw; it < I_B; it += 2 * NGW) conv_stream_items<2>(args.in[I_F1G], FF, WGU1, 1, true, DM, it, NGW, I_B, lane, args.in[I_F1PRE], C8, NCB);
                         for (int it = gw; it < I_B; it += 2 * NGW) conv_stream_items<2>(args.in[I_F1U], FF, WGU1, 2, true, DM, it, NGW, I_B, lane, args.in[I_F1PRE], C8, NCB); } }
#undef CONV_ALL
        for (int m = gw; m < M; m += NGW) {
            const f32x4* xr = (const f32x4*)(x + (size_t)m * DM) + lane; f32x4 v[16]; float ss = 0.f;
            float amax = 1e-20f;
#pragma unroll
            for (int j = 0; j < 16; ++j) { v[j] = xr[64 * j]; ss += (v[j].x * v[j].x + v[j].y * v[j].y) + (v[j].z * v[j].z + v[j].w * v[j].w);
                amax = fmaxf(fmaxf(amax, fmaxf(fabsf(v[j].x), fabsf(v[j].y))), fmaxf(fabsf(v[j].z), fabsf(v[j].w))); }
            const float r = 1.f / sqrtf(wave_sum(ss) * (1.f / DM) + EPS), am = wave_max(amax), qs = 127.f / am; if (lane == 0) { RS[m] = r; RS[5 * M + m] = am * r * (1.f / 127.f); }
#pragma unroll
            for (int j = 0; j < 16; ++j) ((unsigned*)((unsigned char*)MG + (size_t)m * DM) + lane)[64 * j] = pk4_i8(v[j].x * qs, v[j].y * qs, v[j].z * qs, v[j].w * qs);
            v2u* o8 = (v2u*)(ACT + (size_t)m * DM) + lane;
#pragma unroll
            for (int j = 0; j < 16; ++j) { v2u w; w.x = pg8::cvt_pk_bf16(v[j].x, v[j].y); w.y = pg8::cvt_pk_bf16(v[j].z, v[j].w); o8[64 * j] = w; }
        }
        const int gt = vcu * NTHR + tid, NGT = G * NTHR;
        for (int i = gt; i < SEQ * 64; i += NGT) { const int s = i >> 6, f = i & 63;
            const float inv = powf(10000.0f, -(float)(2 * f) / 128.0f); const float ang = (float)s * inv;
            const double a = (double)ang; const double k = rint(a * 0.15915494309189535); const float rr = (float)(a - k * 6.283185307179586);
            CS[i] = cosf(rr); SN[i] = sinf(rr); }
        for (int i = gt; i < LW; i += NGT) { const float xl = -args.in[I_LAM][i]; SPt[i] = fmaxf(xl, 0.f) + log1pf(expf(-fabsf(xl))); }
    }
    SEAM(0);
    if (IN(1)) {
        { const int xs = bx & 7;
          pg8::Gemm g = pg8::gemm_chunkB8(MG, WGU1, DM, DM, (size_t)512 * DM);
          EpiSwiGLU<2, true, true> E{HB, RS + 5 * M, 1.f / WGI_SCALE};
          { pg8::StaticOrder S; S.init(M, 256 * F1T, G, bx); S.iend = xs + 1;
            pg8::gemm_phase<EpiSwiGLU<2, true, true>, pg8::StaticOrder, 0, false, false, true>(lds + RING_OFF, g, S, E, WV); }
        { PHASE_IDS();
          constexpr int I_OO = (DM / 8) * (DM / 256);
#define CONV_ALL(Wsrc, Ncols, Wdst, mode_, perm_, K_, nit, gain_) for (int it = gw; it < (nit); it += 2 * NGW) conv_stream_items<2>(Wsrc, Ncols, Wdst, mode_, perm_, K_, it, NGW, nit, lane, gain_)
        {
            constexpr int IB1 = (DM / 8) * I8A0, IB2 = (DM / 8) * (I8B0 - I8A1), I81 = (DM / 16) * 2 * (I8A1 - I8A0), I82 = (DM / 16) * 2 * (INC / 256 - I8B0);
            for (int it = gw; it < IB1; it += 2 * NGW) conv_stream_items<2>(args.in[I_WIN], INC, WIN, 3, true, DM, it, NGW, IB1, lane, args.in[I_MIXPRE], 0, I8A0);
            if (IB2 > 0) for (int it = gw; it < IB2; it += 2 * NGW) conv_stream_items<2>(args.in[I_WIN], INC, WIN, 3, true, DM, it, NGW, IB2, lane, args.in[I_MIXPRE], 256 * I8A1, I8B0 - I8A1);
            if (I81 > 0) for (int it = gw; it < I81; it += 2 * NGW) conv_stream_items8<2>(args.in[I_WIN], INC, (unsigned char*)WIN, DM, it, NGW, I81, lane, WGI_SCALE, 3, true, args.in[I_MIXPRE], 2 * (I8A1 - I8A0), (size_t)512 * DM, true, 256 * I8A0);
            for (int it = gw; it < I82; it += 2 * NGW) conv_stream_items8<2>(args.in[I_WIN], INC, (unsigned char*)WIN, DM, it, NGW, I82, lane, WGI_SCALE, 3, true, args.in[I_MIXPRE], 2 * (INC / 256 - I8B0), (size_t)512 * DM, true, 256 * I8B0); }
        {
          const int nunP1 = (M / 256) * (2 * FF / 256), fullP1 = nunP1 % G;
          if (fullP1 == 0) { CONV_ALL(args.in[I_WO], DM, WOt, 0, false, DM, I_OO, nullptr); }
          else if (bx < fullP1) { const int nw = fullP1 * NWAVES; for (int it = bx * NWAVES + wave; it < I_OO; it += 2 * nw) conv_stream_items<2>(args.in[I_WO], DM, WOt, 0, false, DM, it, nw, I_OO, lane, nullptr); } }
        { constexpr int I_8 = (DM / 16) * (FF / 128);
          for (int it = gw; it < I_8; it += 2 * NGW) conv_stream_items8<2>(args.in[I_F2G], FF, (unsigned char*)WGU2, DM, it, NGW, I_8, lane, WGI_SCALE, 1, true, args.in[I_F2PRE], FF / 128, (size_t)256 * DM, true);
          for (int it = gw; it < I_8; it += 2 * NGW) conv_stream_items8<2>(args.in[I_F2U], FF, (unsigned char*)WGU2, DM, it, NGW, I_8, lane, WGI_SCALE, 2, true, args.in[I_F2PRE], FF / 128, (size_t)256 * DM, true); }
#undef CONV_ALL
        }
          { pg8::StaticOrder S; S.init(M, 256 * F1T, G, bx); S.ibeg = xs + 1;
            pg8::gemm_phase<EpiSwiGLU<2, true, true>, pg8::StaticOrder, 0, false, false, true>(lds + RING_OFF, g, S, E, WV); } }
        if (F1T < 2 * FF / 256) {
        pg8::Gemm g = pg8::gemm_chunkB(ACT, ACT, WGU1, WGU1, DM, DM, 2 * FF); pg8::StaticOrder S; S.init(M, 2 * FF - 256 * F1T, G, bx, F1T);
        EpiSwiGLU<2> E{HB, RS, 1.f};
        pg8::gemm_phase<EpiSwiGLU<2>, pg8::StaticOrder, 0, false>(lds + RING_OFF, g, S, E, WV); }
        { const int nun = (M / 256) * ((F1T < 2 * FF / 256) ? 2 * FF / 256 - F1T : 2 * FF / 256), full = nun % G; constexpr int NI = (FF / 32) * (DM / 64);
          PHASE_IDS();
          if (full != 0) { if (bx >= full) { const int nw = (G - full) * NWAVES;
              for (int it = (bx - full) * NWAVES + wave; it < NI; it += 2 * nw) conv_had_items<2>(args.in[I_F1D], DM, (unsigned char*)WD1, FF, it, nw, NI, lane, WQ_SCALE); } }
          else { for (int it = gw; it < NI; it += 2 * NGW) conv_had_items<2>(args.in[I_F1D], DM, (unsigned char*)WD1, FF, it, NGW, NI, lane, WQ_SCALE); } }
    }
    SEAM(1);
    if (IN(2)) {
        pg8::Gemm g = pg8::gemm_chunkB8(HB, WD1, FF, FF); pg8::StaticOrder S; S.init(M, DM, G, bx);
        EpiF32I E{FB, DM, DQ_SCALE};
        pg8::gemm_phase<EpiF32I, pg8::StaticOrder, 0, false, false, true>(lds + RING_OFF, g, S, E, WV);
    }
    SEAM(2);
    if (IN(3)) {
        PHASE_IDS();
        LAS f32x4* g1 = (LAS f32x4*)(lds + RING_OFF);
        for (int i = tid; i < DM / 4; i += NTHR) g1[i] = ((const f32x4*)args.in[I_F1POST])[i];
        __syncthreads();
        thin_phase<0>(FB, ACT, XR, RS + M, nullptr, g1, gw, NGW, lane, (unsigned char*)MG, RS + 3 * M);
        __syncthreads();
    }
    SEAM(3);
    if (IN(4)) {
        { pg8::Gemm g = pg8::gemm_chunkB(XR, XR, WIN, WIN, DM, DM, INC); EpiProj E{QB, SAb, CS, SN, KM, RS + M};
          pg8::StaticOrder S; S.init(M, 256 * (I8A0 + I8B0 - I8A1), G, bx, 0, I8A0, I8A1 - I8A0); pg8::gemm_phase<EpiProj, pg8::StaticOrder, 0, false>(lds + RING_OFF, g, S, E, WV); }
        { pg8::Gemm g = pg8::gemm_chunkB8(MG, WIN, DM, DM, (size_t)512 * DM); EpiProjI E{EpiProj{QB, SAb, CS, SN, KM, RS + M}, RS + 3 * M, 1.f / WGI_SCALE};
          pg8::StaticOrder S; S.init(M, 256 * (I8A1 - I8A0) + INC - 256 * I8B0, G, bx, I8A0, I8A1 - I8A0, I8B0 - I8A1); pg8::gemm_phase<EpiProjI, pg8::StaticOrder, 0, false, false, true>(lds + RING_OFF, g, S, E, WV); }
    }
    SEAM(4);
    if (IN(7)) {
        PHASE_IDS();
        {
            typedef att::bf16x8 bf8; typedef att::f32x16 f16v;
            LAS float* cwl = (LAS float*)(lds + RING_OFF);
            LAS float* summ = (LAS float*)(lds + RING_OFF + 4096);
            const float* cw = args.in[I_CONVW]; const float* cb = args.in[I_CONVB];
            static_assert(NB * 64 * 8 * 8 * 2 == 2 * (AW / 8) * (DM / 64), "hosted conversion groups");
            for (int unit = vcu; unit < NB * 64; unit += G) {
                const int b = unit >> 6, n = (unit >> 2) & 15, q = unit & 3, C0 = 128 * n + 32 * q;
                int tl = tid_of(WV); asm volatile("" : "+v"(tl));
                const int lane2 = tl & 63, d = lane2 & 31, hi = lane2 >> 5, wave2 = __builtin_amdgcn_readfirstlane(tl >> 6);
                LAS unsigned char* xs = lds + RING_OFF + 8192 + wave2 * 12288;
                LAS unsigned char* gs = xs + 9728; LAS unsigned char* ys = xs;
                __syncthreads();
                for (int i = tl; i < 5 * 128; i += NTHR) { const int tap = i >> 7, c = i & 127; cwl[i] = tap < 4 ? cw[tap * LW + 128 * n + c] : cb[128 * n + c]; }
                LAS v4u* wfr = (LAS v4u*)(lds + RING_OFF + 8192 + 8 * 12288);
                { const int ks = wave2; float wa[8], wx[8];
#pragma unroll
                    for (int e = 0; e < 8; ++e) { const size_t o = ((size_t)n * 128 + 16 * ks + 8 * hi + e) * 128 + 32 * q + d; wa[e] = args.in[I_RGWA][o]; wx[e] = args.in[I_RGWX][o]; }
                    v4u pa, px; pa.x = pg8::cvt_pk_bf16(wa[0], wa[1]); pa.y = pg8::cvt_pk_bf16(wa[2], wa[3]); pa.z = pg8::cvt_pk_bf16(wa[4], wa[5]); pa.w = pg8::cvt_pk_bf16(wa[6], wa[7]);
                    px.x = pg8::cvt_pk_bf16(wx[0], wx[1]); px.y = pg8::cvt_pk_bf16(wx[2], wx[3]); px.z = pg8::cvt_pk_bf16(wx[4], wx[5]); px.w = pg8::cvt_pk_bf16(wx[6], wx[7]);
                    wfr[(ks * 64 + lane2) * 2] = pa; wfr[(ks * 64 + lane2) * 2 + 1] = px; }
                const float bav = args.in[I_RGBA][C0 + d], bxv = args.in[I_RGBX][C0 + d], spv = SPt[C0 + d];
                float Sround = 0.f;
                v4u xq[9], gq[2];
#define LRU_LOAD(rho_) do { const int t0_ = 256 * (rho_) + 32 * wave2; \
                    _Pragma("unroll") for (int i_ = 0; i_ < 9; ++i_) { const int pc = lane2 + 64 * i_, rr = pc >> 4, c16 = pc & 15, ts = t0_ - 3 + rr; xq[i_] = (v4u){0u, 0u, 0u, 0u}; \
                        if (pc < 560 && ts >= 0) xq[i_] = *(const v4u*)(XREC + ((size_t)b * SEQ + ts) * LW + 128 * n + 8 * c16); } \
                    _Pragma("unroll") for (int i_ = 0; i_ < 2; ++i_) { const int pc = lane2 + 64 * i_, rr = pc >> 2, c16 = pc & 3; gq[i_] = *(const v4u*)(XGATE + ((size_t)b * SEQ + t0_ + rr) * LW + C0 + 8 * c16); } } while (0)
                LRU_LOAD(0);
                __syncthreads();
#pragma unroll 1
                for (int rho = 0; rho < 8; ++rho) {
                    const int t0 = 256 * rho + 32 * wave2;
#pragma unroll
                    for (int i_ = 0; i_ < 9; ++i_) { const int pc = lane2 + 64 * i_; if (pc < 560) *(LAS v4u*)(xs + (pc >> 4) * 272 + (pc & 15) * 16) = xq[i_]; }
#pragma unroll
                    for (int i_ = 0; i_ < 2; ++i_) { const int pc = lane2 + 64 * i_; *(LAS v4u*)(gs + (pc >> 2) * 80 + (pc & 3) * 16) = gq[i_]; }
                    if (rho < 7) LRU_LOAD(rho + 1);
                    float cvl[2][8]; const int cg0 = ((unit * 8 + rho) * 8 + wave2) * 2;
#pragma unroll
                    for (int gi = 0; gi < 2; ++gi) { const int gid = cg0 + gi, jm = gid >> 14, gl = gid & 16383, kc = gl >> 6, nbq = gl & 63;
                        const float* wsrc = (jm == 0 ? args.in[I_WAO] : args.in[I_WRO]) + (size_t)(8 * kc) * DM + 64 * nbq + lane2;
#pragma unroll
                        for (int e = 0; e < 8; ++e) cvl[gi][e] = wsrc[(size_t)e * DM]; }
                    LDS_WAIT();
                    f16v accA = {}, accX = {}, accI = {};
#pragma unroll
                    for (int ks = 0; ks < 8; ++ks) {
                        const int cc = 16 * ks + 8 * hi;
                        f2v xc[4];
                        { const f32x4 b0 = *(const LAS f32x4*)(cwl + 512 + cc), b1 = *(const LAS f32x4*)(cwl + 512 + cc + 4);
                          xc[0] = (f2v){b0.x, b0.y}; xc[1] = (f2v){b0.z, b0.w}; xc[2] = (f2v){b1.x, b1.y}; xc[3] = (f2v){b1.z, b1.w}; }
#pragma unroll
                        for (int tap = 0; tap < 4; ++tap) {
                            const v4u xw = *(const LAS v4u*)(xs + (d + tap) * 272 + cc * 2);
                            const f32x4 w0 = *(const LAS f32x4*)(cwl + tap * 128 + cc), w1 = *(const LAS f32x4*)(cwl + tap * 128 + cc + 4);
                            xc[0] += (f2v){w0.x, w0.y} * (f2v){bflo(xw.x), bfhi(xw.x)}; xc[1] += (f2v){w0.z, w0.w} * (f2v){bflo(xw.y), bfhi(xw.y)};
                            xc[2] += (f2v){w1.x, w1.y} * (f2v){bflo(xw.z), bfhi(xw.z)}; xc[3] += (f2v){w1.z, w1.w} * (f2v){bflo(xw.w), bfhi(xw.w)}; }
                        v4u af; af.x = pg8::cvt_pk_bf16(xc[0].x, xc[0].y); af.y = pg8::cvt_pk_bf16(xc[1].x, xc[1].y); af.z = pg8::cvt_pk_bf16(xc[2].x, xc[2].y); af.w = pg8::cvt_pk_bf16(xc[3].x, xc[3].y);
                        const bf8 Af = __builtin_bit_cast(bf8, af);
                        const int e1 = 32 * q + d - cc;
                        v4u idw; idw.x = (e1 == 0) ? 0x00003F80u : (e1 == 1 ? 0x3F800000u : 0u); idw.y = (e1 == 2) ? 0x00003F80u : (e1 == 3 ? 0x3F800000u : 0u);
                        idw.z = (e1 == 4) ? 0x00003F80u : (e1 == 5 ? 0x3F800000u : 0u); idw.w = (e1 == 6) ? 0x00003F80u : (e1 == 7 ? 0x3F800000u : 0u);
                        const bf8 Bak = __builtin_bit_cast(bf8, wfr[(ks * 64 + lane2) * 2]), Bxk = __builtin_bit_cast(bf8, wfr[(ks * 64 + lane2) * 2 + 1]);
                        accA = __builtin_amdgcn_mfma_f32_32x32x16_bf16(Af, Bak, accA, 0, 0, 0);
                        accX = __builtin_amdgcn_mfma_f32_32x32x16_bf16(Af, Bxk, accX, 0, 0, 0);
                        accI = __builtin_amdgcn_mfma_f32_32x32x16_bf16(Af, __builtin_bit_cast(bf8, idw), accI, 0, 0, 0);
                    }
                    float Pp[16], Hl[16], gA[4], gH[4];
#pragma unroll
                    for (int jp = 0; jp < 2; ++jp) {
                        constexpr float L2E = 1.4426950408889634f; const float c8 = -8.f * spv * L2E, c16 = -16.f * spv;
                        f2v pp = {1.f, 1.f}, hh = {0.f, 0.f};
#pragma unroll
                        for (int k = 0; k < 4; ++k) { const int r0 = 8 * jp + k, r1 = r0 + 4;
                            const f2v ea = ((f2v){accA[r0], accA[r1]} + bav) * -L2E, ex = ((f2v){accX[r0], accX[r1]} + bxv) * -L2E;
                            const f2v da = (f2v){__builtin_amdgcn_exp2f(ea.x), __builtin_amdgcn_exp2f(ea.y)} + 1.f, dx = (f2v){__builtin_amdgcn_exp2f(ex.x), __builtin_amdgcn_exp2f(ex.y)} + 1.f;
                            const f2v rg = {__builtin_amdgcn_rcpf(da.x), __builtin_amdgcn_rcpf(da.y)}, ig = {__builtin_amdgcn_rcpf(dx.x), __builtin_amdgcn_rcpf(dx.y)};
                            const f2v l2 = rg * c8, x = rg * c16;
                            const f2v av = {__builtin_amdgcn_exp2f(l2.x), __builtin_amdgcn_exp2f(l2.y)};
                            f2v p = x * 0.0013888889f + 0.0083333338f; p = p * x + 0.041666668f; p = p * x + 0.16666667f; p = p * x + 0.5f; p = p * x + 1.f; p = -x * p;
                            const f2v alt = 1.f - av * av;
                            const f2v ome = {x.x > -0.3f ? p.x : alt.x, x.y > -0.3f ? p.y : alt.y};
                            const f2v uv = (f2v){accI[r0], accI[r1]} * ig * (f2v){__builtin_amdgcn_sqrtf(ome.x), __builtin_amdgcn_sqrtf(ome.y)};
                            hh = av * hh + uv; pp = pp * av; Pp[r0] = pp.x; Pp[r1] = pp.y; Hl[r0] = hh.x; Hl[r1] = hh.y; }
                        gA[2 * jp] = pp.x; gA[2 * jp + 1] = pp.y; gH[2 * jp] = hh.x; gH[2 * jp + 1] = hh.y; }
                    float cin[4], pin[4]; float sl = 0.f, pl = 1.f;
#pragma unroll
                    for (int j = 0; j < 4; ++j) { const float oA = __shfl_xor(gA[j], 32), oH = __shfl_xor(gH[j], 32);
                        const float fA = hi ? oA : gA[j], fH = hi ? oH : gH[j], sA = hi ? gA[j] : oA, sH = hi ? gH[j] : oH;
                        const float c1 = sl, p1 = pl; sl = fA * sl + fH; pl *= fA; const float c2 = sl, p2 = pl; sl = sA * sl + sH; pl *= sA;
                        cin[j] = hi ? c2 : c1; pin[j] = hi ? p2 : p1; }
                    LAS float* sm = summ + (rho & 1) * 512;
                    if (hi == 0) { sm[wave2 * 64 + d] = pl; sm[wave2 * 64 + 32 + d] = sl; }
                    __syncthreads();
                    float s = Sround, myin = 0.f;
#pragma unroll
                    for (int w2 = 0; w2 < 8; ++w2) { const float A2 = sm[w2 * 64 + d], H2 = sm[w2 * 64 + 32 + d]; if (w2 == wave2) myin = s; s = A2 * s + H2; }
                    Sround = s;
#pragma unroll
                    for (int j = 0; j < 4; ++j) { const float ci = cin[j] + pin[j] * myin;
#pragma unroll
                        for (int k = 0; k < 4; ++k) { const int r = 4 * j + k, tr = k + 8 * j + 4 * hi;
                            const float h = Hl[r] + Pp[r] * ci;
                            const float gte = __builtin_bit_cast(float, (unsigned)*(const LAS unsigned short*)(gs + tr * 80 + d * 2) << 16);
                            *(LAS unsigned short*)(ys + tr * 80 + d * 2) = (unsigned short)f2bf(h * gte); } }
                    LDS_WAIT();
#pragma unroll
                    for (int i_ = 0; i_ < 2; ++i_) { const int pc = lane2 + 64 * i_, rr = pc >> 2, c16 = pc & 3;
                        *(v4u*)(YREC + ((size_t)b * SEQ + t0 + rr) * LW + C0 + 8 * c16) = *(const LAS v4u*)(ys + rr * 80 + c16 * 16); }
#pragma unroll
                    for (int gi = 0; gi < 2; ++gi) { const int gid = cg0 + gi, jm = gid >> 14, gl = gid & 16383, kc = gl >> 6, nbq = gl & 63;
                        int r = 64 * nbq + lane2; r = (r & ~31) + invperm32(r & 31);
                        bf16* wdst = jm == 0 ? WAO : WRO; const int Kj = AW;
                        v4u o; o.x = pg8::cvt_pk_bf16(cvl[gi][0], cvl[gi][1]); o.y = pg8::cvt_pk_bf16(cvl[gi][2], cvl[gi][3]); o.z = pg8::cvt_pk_bf16(cvl[gi][4], cvl[gi][5]); o.w = pg8::cvt_pk_bf16(cvl[gi][6], cvl[gi][7]);
                        *(GAS v4u*)(wdst + ((((size_t)(r >> 8) * (Kj >> 6) + (kc >> 3)) * 8 + (kc & 7)) * 256 + (r & 255)) * 8) = o; }
                }
#undef LRU_LOAD
            }
            __syncthreads();
        }
        {
            typedef unsigned short abf;
            char* alds = (char*)lds_raw;
            LAS float* kml = (LAS float*)(lds + 69632);
            LAS unsigned char* rmask = (LAS unsigned char*)(lds + 73728);
            for (int pr_ = vcu; pr_ < NB * NH * 4; pr_ += G) {
                const int bh = pr_ >> 2, j0 = pr_ & 3, b = bh / NH, h = bh % NH;
                int tg = tid_of(WV); asm volatile("" : "+v"(tg));
                {
                    const int jmax = 7 - j0;
                    __syncthreads();
                    for (int idx = tg; idx < jmax * 128; idx += NTHR) { const int n = idx >> 7, d = idx & 127; const size_t ko = ((size_t)(b * 8 + n)) * AW + h * HD + d;
                        kml[idx] = (KM[ko] + KM[(size_t)32 * AW + ko]) * (1.f / 256.f); }
                    __syncthreads();
                    const int pass = __builtin_amdgcn_readfirstlane(tg >> 8), row = tg & 255, jb = pass ? 7 - j0 : j0;
                    {
                        const v4u* qp = (const v4u*)(QB + ((size_t)b * SEQ + jb * 256 + row) * AW + h * HD);
                        float gsc[7];
#pragma unroll
                        for (int n = 0; n < 7; ++n) gsc[n] = 0.f;
#pragma unroll 2
                        for (int c = 0; c < 16; ++c) { const v4u qw = qp[c];
                            const float qv[8] = {bflo(qw.x), bfhi(qw.x), bflo(qw.y), bfhi(qw.y), bflo(qw.z), bfhi(qw.z), bflo(qw.w), bfhi(qw.w)};
#pragma unroll
                            for (int n = 0; n < 7; ++n) if (n < jb) { const f32x4 ka = *(const LAS f32x4*)(kml + n * 128 + 8 * c), kb = *(const LAS f32x4*)(kml + n * 128 + 8 * c + 4);
                                gsc[n] += qv[0] * ka.x + qv[1] * ka.y + qv[2] * ka.z + qv[3] * ka.w + qv[4] * kb.x + qv[5] * kb.y + qv[6] * kb.z + qv[7] * kb.w; } }
                        unsigned sel = 0u;
#pragma unroll
                        for (int k = 0; k < MOBA_TOPK; ++k) { int best = -1; float bv = -__builtin_inff();
#pragma unroll
                            for (int n = 0; n < 7; ++n) if (n < jb && !((sel >> n) & 1u) && gsc[n] > bv) { bv = gsc[n]; best = n; }
                            if (best >= 0) sel |= 1u << best; }
                        rmask[pass * 256 + row] = (unsigned char)sel;
                    }
                }
                __syncthreads();
                const abf* Qh = QB + (size_t)b * SEQ * AW + h * HD; const abf* Kh = KB + (size_t)b * SEQ * AW + h * HD; const abf* Vh = VB + (size_t)b * SEQ * AW + h * HD; abf* Oh = ATT + (size_t)b * SEQ * AW + h * HD;
                att::BlockRef<abf, abf> c0, c1;
                c0.Q = Qh + (size_t)(j0 * 256) * AW; c0.K = Kh; c0.V = Vh; c0.O = Oh + (size_t)(j0 * 256) * AW; c0.P0 = j0 * 256;
                c1.Q = Qh + (size_t)((7 - j0) * 256) * AW; c1.K = Kh; c1.V = Vh; c1.O = Oh + (size_t)((7 - j0) * 256) * AW; c1.P0 = (7 - j0) * 256;
                att::Seam<abf> Sm;
                att::causal_swa_prime<abf, abf>(c0, 1 << 30, alds, Sm, WV);
                att::causal_swa_block<abf, abf>(c0, c1, SEQ, 1 << 30, alds, Sm, (const LAS unsigned char*)(lds + 73728), WV);
                att::causal_swa_block<abf, abf>(c1, c1, SEQ, 1 << 30, alds, Sm, (const LAS unsigned char*)(lds + 73728 + 256), WV);
                __syncthreads();
            }
        }
    }
    SEAM(7);
    if (IN(8)) {
        pg8::Gemm g = pg8::gemm_chunkB(ATT, YREC, WAO, WRO, AW, AW, DM); pg8::StaticOrder2 S; S.init(M, DM, G, bx);
        EpiMerge E{SAb, SBb, MG};
        pg8::gemm_phase<EpiMerge, pg8::StaticOrder2, 1, false>(lds + RING_OFF, g, S, E, WV);
    }
    SEAM(8);
    if (IN(9)) {
        pg8::Gemm g = pg8::gemm_chunkB(MG, MG, WOt, WOt, DM, DM, DM); pg8::StaticOrder S; S.init(M, DM, G, bx);
        EpiF32 E{FB, DM, 1.f};
        pg8::gemm_phase<EpiF32, pg8::StaticOrder, 0, false>(lds + RING_OFF, g, S, E, WV);
    }
    SEAM(9);
    if (IN(10)) {
        PHASE_IDS();
        LAS f32x4* g1 = (LAS f32x4*)(lds + RING_OFF);
        for (int i = tid; i < DM / 4; i += NTHR) g1[i] = ((const f32x4*)args.in[I_MIXPOST])[i];
        __syncthreads();
        thin_phase<1>(FB, nullptr, XR, RS + 2 * M, nullptr, g1, gw, NGW, lane, (unsigned char*)ACT, RS + 4 * M);
        __syncthreads();
    }
    SEAM(10);
    if (IN(11)) {
        pg8::Gemm g = pg8::gemm_chunkB8(ACT, WGU2, DM, DM, (size_t)256 * DM); pg8::StaticOrder S; S.init(M, 2 * FF, G, bx);
        EpiSwiGLU<2, true, true> E{HB, RS + 4 * M, 1.f / WGI_SCALE};
        pg8::gemm_phase<EpiSwiGLU<2, true, true>, pg8::StaticOrder, 0, false, false, true>(lds + RING_OFF, g, S, E, WV);
        { const int nun = (M / 256) * (2 * FF / 256), full = nun % G; constexpr int NI = (FF / 32) * (DM / 64);
          PHASE_IDS();
          if (full != 0) { if (bx >= full) { const int nw = (G - full) * NWAVES;
              for (int it = (bx - full) * NWAVES + wave; it < NI; it += 2 * nw) conv_had_items<2>(args.in[I_F2D], DM, (unsigned char*)WD2, FF, it, nw, NI, lane, WQ_SCALE); } }
          else { for (int it = gw; it < NI; it += 2 * NGW) conv_had_items<2>(args.in[I_F2D], DM, (unsigned char*)WD2, FF, it, NGW, NI, lane, WQ_SCALE); } }
    }
    SEAM(11);
    if (IN(12)) {
        pg8::Gemm g = pg8::gemm_chunkB8(HB, WD2, FF, FF); pg8::StaticOrder S; S.init(M, DM, G, bx);
        EpiF32I E{FB, DM, DQ_SCALE};
        pg8::gemm_phase<EpiF32I, pg8::StaticOrder, 0, false, false, true>(lds + RING_OFF, g, S, E, WV);
    }
    SEAM(12);
    if (IN(13)) {
        PHASE_IDS();
        LAS f32x4* g1 = (LAS f32x4*)(lds + RING_OFF);
        for (int i = tid; i < DM / 4; i += NTHR) g1[i] = ((const f32x4*)args.in[I_F2POST])[i];
        __syncthreads();
        thin_phase<2>(FB, nullptr, XR, nullptr, args.out, g1, gw, NGW, lane);
    }
#undef IN
#undef SEAM
}
constexpr int NPHASE = 14;

extern "C" void kernel_launch(void* const* d_in, const int* in_sizes, int n_in, void* d_out, int out_size, void* d_ws, size_t ws_size, hipStream_t stream) {
    static int grid = 0;
    if (grid == 0) {
        if (n_in != 24 || in_sizes[0] != M * DM || out_size != M * DM || ws_size < WS_END) { fprintf(stderr, "kernel_launch: unexpected shapes (n_in %d, in0 %d, out %d, ws %zu); nothing launched\n", n_in, n_in > 0 ? in_sizes[0] : -1, out_size, ws_size); grid = -1; return; }
        int dev = 0, cus = 0, per_cu = 0;
        if (hipGetDevice(&dev) != hipSuccess || hipDeviceGetAttribute(&cus, hipDeviceAttributeMultiprocessorCount, dev) != hipSuccess) { grid = -1; return; }
        if (hipFuncSetAttribute((const void*)fwd, hipFuncAttributeMaxDynamicSharedMemorySize, LDS_BYTES) != hipSuccess) { fprintf(stderr, "kernel_launch: hipFuncSetAttribute failed\n"); grid = -1; return; }
        if (hipOccupancyMaxActiveBlocksPerMultiprocessor(&per_cu, (const void*)fwd, NTHR, LDS_BYTES) != hipSuccess || per_cu < 1) fprintf(stderr, "kernel_launch: occupancy query reports %d\n", per_cu);
        (void)hipGetLastError();
        grid = cus;
    }
    if (grid < 0) return;
    if (hipMemsetAsync((char*)d_ws + WS_CTL, 0, CTL_ZERO_BYTES, stream) != hipSuccess) return;
    Args a{};
    for (int i = 0; i < 24; ++i) a.in[i] = (const float*)d_in[i];
    a.out = (float*)d_out; a.ws = (unsigned char*)d_ws;
#if MK_PER_PHASE
    for (int p = 0; p < NPHASE; ++p) { a.ph_lo = p; a.ph_hi = p + 1; hipLaunchKernelGGL(fwd, dim3(grid), dim3(NTHR), LDS_BYTES, stream, a); }
#else
    a.ph_lo = 0; a.ph_hi = NPHASE; hipLaunchKernelGGL(fwd, dim3(grid), dim3(NTHR), LDS_BYTES, stream, a);
#endif
    const hipError_t le = hipPeekAtLastError();
    if (le != hipSuccess) fprintf(stderr, "kernel_launch: launch failed: %s\n", hipGetErrorName(le));
}
```

```cpp
#include <hip/hip_runtime.h>
#include <cstdio>
#include <cstdint>

#ifndef MK_PER_PHASE
#define MK_PER_PHASE 0
#endif

__device__ __forceinline__ int tid_of(int wv) { return wv * 64 + (int)__builtin_amdgcn_mbcnt_hi(~0u, __builtin_amdgcn_mbcnt_lo(~0u, 0u)); }
namespace pg8 {
#define PG8_LAS __attribute__((address_space(3)))
typedef unsigned short bf16_t;
typedef short bf16x8 __attribute__((ext_vector_type(8)));
typedef float f32x4 __attribute__((ext_vector_type(4)));
typedef unsigned u32x4 __attribute__((ext_vector_type(4)));
typedef int i32x4 __attribute__((ext_vector_type(4)));
typedef int i32x8 __attribute__((ext_vector_type(8)));
constexpr int BM = 256, BK = 64, HALF = 128, HTB = HALF * BK * 2, STAGE_BYTES = 8 * HTB, NXCD = 8, WGM = 8;

__host__ __device__ __forceinline__ int lds_byte(int r, int c) { const int st = (r >> 4) * 2 + (c >> 5), rr = r & 15, cc = c & 31, ob = rr * 64 + cc * 2; return st * 1024 + (ob ^ (((ob >> 9) & 1) << 5)); }
__host__ __device__ __forceinline__ void stage_rc(int b, int& R, int& C) { const int st = b / 1024, sb = b % 1024, swz = sb ^ (((sb >> 9) & 1) << 5); R = (st >> 1) * 16 + swz / 64; C = (st & 1) * 32 + (swz % 64) / 2; }
__host__ __device__ __forceinline__ int perm32(int rho) { const int n = rho >> 4, i = rho & 15; return 8 * (i >> 2) + 4 * n + (i & 3); }

struct Unit { int pm, pn, seg; };
struct Gemm { const bf16_t* A0; const bf16_t* A1; const bf16_t* B0; const bf16_t* B1; int lda, ldb, nt; int kstepB; size_t tileB; int nb; };
__host__ __device__ __forceinline__ Gemm gemm_tiledB(const bf16_t* A0, const bf16_t* A1, const bf16_t* B0, const bf16_t* B1, int lda, int K) { return Gemm{A0, A1, B0, B1, lda, 64, K / 64, 32768, (size_t)256 * K, 0}; }
__host__ __device__ __forceinline__ Gemm gemm_chunkB(const bf16_t* A0, const bf16_t* A1, const bf16_t* B0, const bf16_t* B1, int lda, int K, int) { return Gemm{A0, A1, B0, B1, lda, 0, K / 64, 32768, (size_t)256 * K, 256}; }
__host__ __device__ __forceinline__ Gemm gemm_chunkB8(const void* A, const void* B, int lda, int K, size_t tile_bytes = 0) { return Gemm{(const bf16_t*)A, (const bf16_t*)A, (const bf16_t*)B, (const bf16_t*)B, lda, 0, K / 128, 32768, tile_bytes ? tile_bytes / 2 : (size_t)128 * K, 256}; }
__host__ __device__ __forceinline__ Gemm gemm_rowB(const bf16_t* A0, const bf16_t* A1, const bf16_t* B0, const bf16_t* B1, int lda, int ldb, int K) { return Gemm{A0, A1, B0, B1, lda, ldb, K / 64, 128, (size_t)256 * ldb, 0}; }

struct StaticOrder {
    int nM, nN, nwg, G, c, pn0, gap_at, gap_len, ibeg, iend;
    __host__ __device__ void init(int M, int N, int G_, int c_, int pn0_ = 0, int gap_at_ = 1 << 30, int gap_len_ = 0) { nM = M / BM; nN = N / BM; nwg = nM * nN; G = G_; c = c_; pn0 = pn0_; gap_at = gap_at_; gap_len = gap_len_; ibeg = 0; iend = 1 << 30; }
    __host__ __device__ bool tile(long L, Unit& u) const {
        if (L >= nwg) return false;
        int wgid = (int)L; { const int q = nwg / NXCD, r = nwg % NXCD, xcd = wgid % NXCD, off = wgid / NXCD; wgid = (xcd < r ? xcd * (q + 1) : r * (q + 1) + (xcd - r) * q) + off; }
        const int nig = WGM * nN, gid = wgid / nig, fm = gid * WGM, gsz = (nM - fm) < WGM ? (nM - fm) : WGM;
        u.pm = fm + ((wgid % nig) % gsz); { const int p = (wgid % nig) / gsz; u.pn = pn0 + p + (p >= gap_at ? gap_len : 0); } return true;
    }
    __host__ __device__ bool next(int i, Unit& u) const { u.seg = 0; const int idx = ibeg + i; if (idx >= iend) return false; return tile((long)idx * G + c, u); }
};
struct StaticOrder2 : StaticOrder {
    __host__ __device__ bool next(int i, Unit& u) const { const bool ok = tile((long)(i >> 1) * G + c, u); u.seg = i & 1; return ok; }
};

typedef __bf16 bf16x2_t __attribute__((ext_vector_type(2)));
typedef float f32x2_t __attribute__((ext_vector_type(2)));
__device__ __forceinline__ unsigned cvt_pk_bf16(float lo, float hi) { const f32x2_t f = {lo, hi}; const bf16x2_t b = __builtin_convertvector(f, bf16x2_t); return __builtin_bit_cast(unsigned, b); }

template <int MODE, bool FP8> __device__ __forceinline__ const char* a_ptr(const Gemm& g, const Unit& u) {
    const bf16_t* A = (MODE == 1 && u.seg) ? g.A1 : g.A0; size_t off = (size_t)u.pm * BM * g.lda;
    return FP8 ? (const char*)A + off : (const char*)(A + off); }
template <int MODE> __device__ __forceinline__ const char* b_ptr(const Gemm& g, const Unit& u) {
    const bf16_t* B = (MODE == 1 && u.seg) ? g.B1 : g.B0; return (const char*)(B + (size_t)u.pn * g.tileB); }

template <class Epi, class Sched, int MODE, bool ALIGN_EPI, bool FP8 = false, bool I8 = false>
__device__ __forceinline__ void gemm_phase(PG8_LAS unsigned char* lds, const Gemm g, const Sched& S, const Epi& E, const int wv) {
    int tid_ = tid_of(wv); asm volatile("" : "+v"(tid_));
    const int tid = tid_, wid = __builtin_amdgcn_readfirstlane(tid >> 6), lane = tid & 63, wr = wid >> 2, wc = wid & 3, fr = lane & 15, fq = lane >> 4;
    const int nt = g.nt;
    constexpr bool CHB = true;
    unsigned voffA[2], voffB[2];
#pragma unroll
    for (int i = 0; i < 2; ++i) { int R, C; stage_rc(tid * 16 + i * 8192, R, C); const int Rb = Epi::PERM ? ((R & ~31) + perm32(R & 31)) : R;
        voffA[i] = (FP8 || I8) ? (unsigned)(R * g.lda + C * 2) : (unsigned)(R * g.lda + C) * 2u; voffB[i] = CHB ? (unsigned)((4 * i + (wid >> 1)) * 256 + (wid & 1) * 64 + lane) * 16u : (unsigned)(Rb * g.ldb + C) * 2u; }
    const size_t kstep = (size_t)(BK * 2), kstepB = (size_t)g.kstepB;
    const size_t hstepA = (size_t)HALF * g.lda * ((FP8 || I8) ? 1 : 2), hstepB = g.nb ? (size_t)HALF * 16 : (size_t)HALF * g.ldb * 2;
    unsigned voffAh[2], voffBh[2];
#pragma unroll
    for (int i = 0; i < 2; ++i) { voffAh[i] = voffA[i] + (unsigned)hstepA; voffBh[i] = voffB[i] + (unsigned)hstepB; }
    const unsigned ldsw = (unsigned)wid * 1024u;
    const int aoff = lds_byte(wr * 64 + fr, fq * 8), boff = CHB ? (fq * 128 + wc * 32 + fr) * 16 : lds_byte(wc * 32 + fr, fq * 8);
#define PG8_SA(b, h) (((b) * 2 + (h)) * HTB)
#define PG8_SB(b, h) ((4 + (b) * 2 + (h)) * HTB)
#define PG8_STAGE(bufoff, gbase, voff) do { _Pragma("unroll") for (int _i = 0; _i < 2; ++_i) \
        __builtin_amdgcn_global_load_lds((const unsigned*)((const char*)(gbase) + (voff)[_i]), (PG8_LAS unsigned*)(lds + (bufoff) + ldsw + _i * 8192), 16, 0, 0); } while (0)
#define PG8_LD16(p) (*(const PG8_LAS i32x4*)(p))
#define PG8_LDA(dst, b, h) do { if constexpr (FP8) { _Pragma("unroll") for (int m = 0; m < 4; ++m) dst##8[m] = __builtin_shufflevector(PG8_LD16(lds + PG8_SA(b, h) + aoff + m * 2048), PG8_LD16(lds + PG8_SA(b, h) + aoff + m * 2048 + 1024), 0, 1, 2, 3, 4, 5, 6, 7); } else { \
        _Pragma("unroll") for (int m = 0; m < 4; ++m) _Pragma("unroll") for (int k = 0; k < 2; ++k) dst[m][k] = *(const PG8_LAS bf16x8*)(lds + PG8_SA(b, h) + aoff + m * 2048 + k * 1024); } } while (0)
#define PG8_LDB(dst, b, h) do { if constexpr (FP8) { _Pragma("unroll") for (int n = 0; n < 2; ++n) dst##8[n] = __builtin_shufflevector(PG8_LD16(lds + PG8_SB(b, h) + boff + n * 256), PG8_LD16(lds + PG8_SB(b, h) + boff + n * 256 + 8192), 0, 1, 2, 3, 4, 5, 6, 7); } else { \
        _Pragma("unroll") for (int n = 0; n < 2; ++n) _Pragma("unroll") for (int k = 0; k < 2; ++k) dst[n][k] = *(const PG8_LAS bf16x8*)(lds + PG8_SB(b, h) + boff + n * (CHB ? 256 : 2048) + k * (CHB ? 8192 : 1024)); } } while (0)
#define PG8_MMA(ai, bj, At, Bt) do { __builtin_amdgcn_s_setprio(1); if constexpr (FP8) { _Pragma("unroll") for (int m = 0; m < 4; ++m) _Pragma("unroll") for (int n = 0; n < 2; ++n) \
        acc[ai][bj][m][n] = __builtin_amdgcn_mfma_scale_f32_16x16x128_f8f6f4(Bt##8[n], At##8[m], acc[ai][bj][m][n], 0, 0, 0, 0, 0, 0); } else { \
        _Pragma("unroll") for (int m = 0; m < 4; ++m) _Pragma("unroll") for (int n = 0; n < 2; ++n) _Pragma("unroll") for (int k = 0; k < 2; ++k) { \
        if constexpr (I8) acc[ai][bj][m][n] = __builtin_bit_cast(f32x4, __builtin_amdgcn_mfma_i32_16x16x64_i8(__builtin_bit_cast(i32x4, Bt[n][k]), __builtin_bit_cast(i32x4, At[m][k]), __builtin_bit_cast(i32x4, acc[ai][bj][m][n]), 0, 0, 0)); \
        else acc[ai][bj][m][n] = __builtin_amdgcn_mfma_f32_16x16x32_bf16(Bt[n][k], At[m][k], acc[ai][bj][m][n], 0, 0, 0); } } __builtin_amdgcn_s_setprio(0); } while (0)
#define PG8_WAIT_V(n) asm volatile("s_waitcnt vmcnt(" #n ")" ::: "memory")
#define PG8_WAIT_L(n) asm volatile("s_waitcnt lgkmcnt(" #n ")" ::: "memory")
#define PG8_BAR __builtin_amdgcn_s_barrier()
#define PG8_SCHED __builtin_amdgcn_sched_barrier(0)
    Unit cur, nxt; int ui = 0;
    if (!S.next(0, cur)) return;
    f32x4 acc[2][2][4][2];
#pragma unroll
    for (int a = 0; a < 2; ++a)
#pragma unroll
        for (int b = 0; b < 2; ++b)
#pragma unroll
            for (int m = 0; m < 4; ++m)
#pragma unroll
                for (int n = 0; n < 2; ++n) acc[a][b][m][n] = (f32x4){0.f, 0.f, 0.f, 0.f};
    bf16x8 At[4][2], B0[2][2], B1[2][2]; i32x8 At8[4], B08[2], B18[2];
    const char* cA = a_ptr<MODE, (FP8 || I8)>(g, cur); const char* cB = b_ptr<MODE>(g, cur);
    PG8_STAGE(PG8_SB(0, 0), cB, voffB); PG8_STAGE(PG8_SB(0, 1), cB, voffBh); PG8_STAGE(PG8_SA(0, 0), cA, voffA); PG8_STAGE(PG8_SA(0, 1), cA, voffAh);
    if (wr == 1) PG8_BAR;
    PG8_WAIT_V(2); PG8_BAR;
    PG8_STAGE(PG8_SB(1, 0), cB + kstepB, voffB); PG8_STAGE(PG8_SA(1, 0), cA + kstep, voffA); PG8_STAGE(PG8_SB(1, 1), cB + kstepB, voffBh);
    PG8_WAIT_V(6); PG8_BAR;
    for (;;) {
        const bool has_next = S.next(ui + 1, nxt);
        float rsv[8];
        if constexpr (Epi::HAS_RS) E.load_rs(cur, wr, fr, rsv);
        const char* nA = has_next ? a_ptr<MODE, (FP8 || I8)>(g, nxt) : cA; const char* nB = has_next ? b_ptr<MODE>(g, nxt) : cB;
#pragma nounroll
        for (int t = 0; t < nt; t += 2) {
            const bool last = (t == nt - 2);
            asm volatile("" : "+v"(voffA[0]), "+v"(voffA[1]), "+v"(voffB[0]), "+v"(voffB[1]), "+v"(voffAh[0]), "+v"(voffAh[1]), "+v"(voffBh[0]), "+v"(voffBh[1]));
            const char* a1 = cA + (size_t)(t + 1) * kstep;
            const char* a2 = last ? nA : cA + (size_t)(t + 2) * kstep; const char* b2 = last ? nB : cB + (size_t)(t + 2) * kstepB;
            const char* a3 = a2 + kstep; const char* b3 = b2 + kstepB;
            asm volatile("" : "+s"(a1), "+s"(a2), "+s"(a3), "+s"(b2), "+s"(b3));
            PG8_LDB(B0, 0, 0); PG8_LDB(B1, 0, 1); PG8_SCHED; PG8_LDA(At, 0, 0); PG8_STAGE(PG8_SA(1, 1), a1, voffAh);
            PG8_WAIT_V(8); PG8_WAIT_L(0); PG8_BAR; PG8_MMA(0, 0, At, B0); PG8_MMA(0, 1, At, B1); PG8_BAR; PG8_SCHED;
            PG8_LDA(At, 0, 1); PG8_STAGE(PG8_SB(0, 0), b2, voffB); PG8_STAGE(PG8_SB(0, 1), b2, voffBh); PG8_STAGE(PG8_SA(0, 0), a2, voffA);
            PG8_WAIT_V(8); PG8_WAIT_L(0); PG8_BAR; PG8_MMA(1, 0, At, B0); PG8_MMA(1, 1, At, B1); PG8_BAR; PG8_SCHED;
            PG8_LDB(B0, 1, 0); PG8_LDB(B1, 1, 1); PG8_SCHED; PG8_LDA(At, 1, 0); PG8_STAGE(PG8_SA(0, 1), a2, voffAh);
            PG8_WAIT_V(8); PG8_WAIT_L(0); PG8_BAR; PG8_MMA(0, 0, At, B0); PG8_MMA(0, 1, At, B1); PG8_BAR; PG8_SCHED;
            PG8_LDA(At, 1, 1); PG8_STAGE(PG8_SB(1, 0), b3, voffB); PG8_STAGE(PG8_SB(1, 1), b3, voffBh); PG8_STAGE(PG8_SA(1, 0), a3, voffA);
            PG8_WAIT_V(8); PG8_WAIT_L(0); PG8_BAR; PG8_MMA(1, 0, At, B0); PG8_MMA(1, 1, At, B1); PG8_BAR; PG8_SCHED;
        }
        if constexpr (ALIGN_EPI) { if (wr == 0) PG8_BAR; }
        { int te = tid_of(wv); asm volatile("" : "+v"(te)); const int fre = te & 15, fqe = (te & 63) >> 4;
          if constexpr (Epi::HAS_RS) E(acc, cur, wr, wc, fre, fqe, rsv); else E(acc, cur, wr, wc, fre, fqe); }
        if (!has_next) break;
        if (!(MODE == 1 && cur.seg == 0)) {
#pragma unroll
        for (int a = 0; a < 2; ++a)
#pragma unroll
            for (int b = 0; b < 2; ++b)
#pragma unroll
                for (int m = 0; m < 4; ++m)
#pragma unroll
                    for (int n = 0; n < 2; ++n) acc[a][b][m][n] = (f32x4){0.f, 0.f, 0.f, 0.f};
        }
        cur = nxt; cA = nA; cB = nB; ++ui;
        if constexpr (ALIGN_EPI) { if (wr == 1) PG8_BAR; }
    }
    PG8_WAIT_V(0);
    if constexpr (!ALIGN_EPI) { if (wr == 0) PG8_BAR; }
    PG8_BAR;
#undef PG8_SA
#undef PG8_SB
#undef PG8_STAGE
#undef PG8_LDA
#undef PG8_LDB
#undef PG8_MMA
#undef PG8_WAIT_V
#undef PG8_WAIT_L
#undef PG8_BAR
#undef PG8_SCHED
}
}


namespace att {
constexpr int D = 128, LD = 2048;
constexpr float SCALE = 0.08838834764831845f, THR = 8.f;
constexpr bool WSKIP = false;
constexpr int NW = 8, QBLK = 32, KVBLK = 64, QB = NW * QBLK;
constexpr int SHM_V = KVBLK * D * 2, SHM_K = KVBLK * D * 2;
constexpr int LDS_BYTES = 2 * SHM_V + 2 * SHM_K + NW * 64 * 4;
typedef short bf16x8 __attribute__((ext_vector_type(8)));
typedef short s16x4 __attribute__((ext_vector_type(4)));
typedef float f32x16 __attribute__((ext_vector_type(16)));
typedef float f32x4 __attribute__((ext_vector_type(4)));
typedef unsigned u32x4 __attribute__((ext_vector_type(4)));
template <class A, class Bt> struct same_t { static constexpr bool v = false; };
template <class A> struct same_t<A, A> { static constexpr bool v = true; };
#define KSWZ(row, colB) ((row) * 256 + ((colB) ^ (((row) & 7) << 4)))
#define SBAR() __builtin_amdgcn_sched_barrier(0)
__device__ __forceinline__ int v_st(int k, int c) { const int kk = (k & ~0xC) | ((k & 4) << 1) | ((k & 8) >> 1); return ((kk >> 3) * 4 + (c >> 5)) * 512 + ((kk & 7) * 32 + (c & 31)) * 2; }
__device__ __forceinline__ int v_rd_base(int lane) { return ((lane & 3) << 3) | (((lane >> 2) & 3) << 6) | (((lane >> 4) & 1) << 5) | (((lane >> 5) & 1) << 8); }
constexpr int v_rd_off(int d0, int ks, int half) { return d0 * 512 + ks * 4096 + half * 2048; }
__device__ __forceinline__ int crow(int r, int hi) { return (r & 3) + 8 * (r >> 2) + 4 * hi; }
__device__ __forceinline__ unsigned cvtpk(float lo, float hi) { return pg8::cvt_pk_bf16(lo, hi); }
__device__ __forceinline__ bf16x8 pack8(f32x4 a, f32x4 b) {
    u32x4 w = {cvtpk(a[0], a[1]), cvtpk(a[2], a[3]), cvtpk(b[0], b[1]), cvtpk(b[2], b[3])};
    return *reinterpret_cast<bf16x8*>(&w);
}
template <class T> __device__ __forceinline__ bf16x8 load8(const T* p) {
    if constexpr (same_t<T, float>::v) { return pack8(*(const f32x4*)p, *(const f32x4*)(p + 4)); }
    else { return *reinterpret_cast<const bf16x8*>(p); }
}
__device__ __forceinline__ void mask_tile(f32x16& p0, f32x16& p1, int dq, unsigned W) {
    const float NEG = -__builtin_inff();
#pragma unroll
    for (int r = 0; r < 16; ++r) {
        const int c = (r & 3) + 8 * (r >> 2);
        if ((unsigned)(dq - c) >= W) p0[r] = NEG;
        if ((unsigned)(dq - c - 32) >= W) p1[r] = NEG;
    }
}
__device__ __forceinline__ void partialSM(f32x16& p0, f32x16& p1, float& m_reg, float& mn, float& alpha) {
    float pmax = p0[0]; for (int r = 1; r < 16; ++r) pmax = fmaxf(pmax, p0[r]); for (int r = 0; r < 16; ++r) pmax = fmaxf(pmax, p1[r]);
    { auto rr = __builtin_amdgcn_permlane32_swap(__float_as_uint(pmax), __float_as_uint(pmax), false, false);
      pmax = fmaxf(__uint_as_float(rr[0]), __uint_as_float(rr[1])); }
    constexpr float C2 = 1.4426950408889634f * SCALE;
    if (__builtin_expect(__all((pmax - m_reg) * SCALE <= THR), 1)) { mn = m_reg; alpha = 1.f; }
    else { mn = fmaxf(m_reg, pmax); alpha = __builtin_amdgcn_exp2f((m_reg - mn) * C2); m_reg = mn; }
    const float mnL = -mn * C2;
    for (int r = 0; r < 16; ++r) p0[r] = fmaf(p0[r], C2, mnL); for (int r = 0; r < 16; ++r) p1[r] = fmaf(p1[r], C2, mnL);
    for (int r = 0; r < 16; ++r) p0[r] = __builtin_amdgcn_exp2f(p0[r]);
}
__device__ __forceinline__ void finishSM(f32x16& p0, f32x16& p1, float alpha, float& l_reg, bf16x8& pa0, bf16x8& pa1, bf16x8& pa2, bf16x8& pa3) {
    for (int r = 0; r < 16; ++r) p1[r] = __builtin_amdgcn_exp2f(p1[r]);
    float ps = 0; for (int r = 0; r < 16; ++r) ps += p0[r]; for (int r = 0; r < 16; ++r) ps += p1[r];
    { auto rr = __builtin_amdgcn_permlane32_swap(__float_as_uint(ps), __float_as_uint(ps), false, false);
      ps = __uint_as_float(rr[0]) + __uint_as_float(rr[1]); }
    l_reg = l_reg * alpha + ps;
#define PK4(P, B_, OUT) do { unsigned a0 = cvtpk(P[B_+0], P[B_+1]), a1 = cvtpk(P[B_+2], P[B_+3]);                          \
        unsigned b0 = cvtpk(P[B_+4], P[B_+5]), b1 = cvtpk(P[B_+6], P[B_+7]);                                             \
        auto r0 = __builtin_amdgcn_permlane32_swap(a0, b0, false, false); auto r1 = __builtin_amdgcn_permlane32_swap(a1, b1, false, false); \
        u32x4 w = {r0[0], r1[0], r0[1], r1[1]}; OUT = *reinterpret_cast<bf16x8*>(&w); } while (0)
    PK4(p0, 0, pa0); PK4(p0, 8, pa1); PK4(p1, 0, pa2); PK4(p1, 8, pa3);
#undef PK4
}
template <int KB, bool SK>
__device__ __forceinline__ void qkt(f32x16& p0, f32x16& p1, const char* K_lds, int r32, int hi, const bf16x8* qr, bool act) {
    if (SK && !act) { const float NEG = -__builtin_inff();
#pragma unroll
        for (int r = 0; r < 16; ++r) { p0[r] = NEG; p1[r] = NEG; } return; }
    p0 = f32x16{}; p1 = f32x16{};
    const char* kb[4];
#pragma unroll
    for (int dd = 0; dd < 4; ++dd) kb[dd] = K_lds + KB * SHM_K + KSWZ(r32, (dd * 16 + hi * 8) * 2);
#pragma unroll
    for (int d0 = 0; d0 < 8; ++d0) { const char* a = kb[d0 & 3] + (d0 >> 2) * 128;
        bf16x8 b0 = *reinterpret_cast<const bf16x8*>(a);
        bf16x8 b1 = *reinterpret_cast<const bf16x8*>(a + 32 * 256);
        p0 = __builtin_amdgcn_mfma_f32_32x32x16_bf16(b0, qr[d0], p0, 0, 0, 0);
        p1 = __builtin_amdgcn_mfma_f32_32x32x16_bf16(b1, qr[d0], p1, 0, 0, 0); }
}
template <int VB, bool SK>
__device__ __forceinline__ void pv_tile(f32x16* o, int vb0, bf16x8 pa0, bf16x8 pa1, bf16x8 pa2, bf16x8 pa3, bool act) {
    if (SK && !act) return;
#define TRRD(dst, off) asm volatile("ds_read_b64_tr_b16 %0, %1 offset:%2" : "=&v"(dst) : "v"(vb0), "i"(off) : "memory")
#define PV_D0(d0) do { s16x4 l0, l1, l2, l3, h0, h1, h2, h3; constexpr int b_ = VB * SHM_V + v_rd_off(d0, 0, 0);     \
        TRRD(l0, b_); TRRD(h0, b_ + 2048); TRRD(l1, b_ + 4096); TRRD(h1, b_ + 6144); TRRD(l2, b_ + 8192); TRRD(h2, b_ + 10240); TRRD(l3, b_ + 12288); TRRD(h3, b_ + 14336); \
        asm volatile("s_waitcnt lgkmcnt(0)" ::: "memory"); SBAR();                 \
        o[d0] = __builtin_amdgcn_mfma_f32_32x32x16_bf16(pa0, (bf16x8){l0[0], l0[1], l0[2], l0[3], h0[0], h0[1], h0[2], h0[3]}, o[d0], 0, 0, 0);   \
        o[d0] = __builtin_amdgcn_mfma_f32_32x32x16_bf16(pa1, (bf16x8){l1[0], l1[1], l1[2], l1[3], h1[0], h1[1], h1[2], h1[3]}, o[d0], 0, 0, 0);   \
        o[d0] = __builtin_amdgcn_mfma_f32_32x32x16_bf16(pa2, (bf16x8){l2[0], l2[1], l2[2], l2[3], h2[0], h2[1], h2[2], h2[3]}, o[d0], 0, 0, 0);   \
        o[d0] = __builtin_amdgcn_mfma_f32_32x32x16_bf16(pa3, (bf16x8){l3[0], l3[1], l3[2], l3[3], h3[0], h3[1], h3[2], h3[3]}, o[d0], 0, 0, 0); } while (0)
    PV_D0(0); PV_D0(1); PV_D0(2); PV_D0(3);
#undef PV_D0
#undef TRRD
}

template <class TIn, class TOut> struct BlockRef { const TIn* Q; const TIn* K; const TIn* V; TOut* O; int P0; };
template <class TIn> struct Seam {
    bf16x8 qr[8];
    bf16x8 st_v0, st_v1, st_k0, st_k1; f32x4 sf0, sf1, sf2, sf3;
    f32x4 tq[16];
};
__device__ __forceinline__ int swa_jlo(int P0, int W) { const int lowk = P0 - W + 1; return lowk > 0 ? lowk / KVBLK : 0; }
#define ROW(p, k0, rr) ((p) + (unsigned)(((k0) + (rr)) * LD + sc))
#define VMW() asm volatile("s_waitcnt vmcnt(0)" ::: "memory")
#define VMWN(n) asm volatile("s_waitcnt vmcnt(%0)" :: "i"(n) : "memory")
#define SLOAD_H(Kp, Vp, k0) do { S.st_v0 = load8<TIn>(ROW(Vp, k0, sr)); S.st_v1 = load8<TIn>(ROW(Vp, k0, 32 + sr));              \
                         S.st_k0 = load8<TIn>(ROW(Kp, k0, sr)); S.st_k1 = load8<TIn>(ROW(Kp, k0, 32 + sr)); } while (0)
#define SWRITE_HK(bf) do { *(bf16x8*)(K_lds + (bf) * SHM_K + kws) = S.st_k0; *(bf16x8*)(K_lds + (bf) * SHM_K + kws + 32 * 256) = S.st_k1; } while (0)
#define SWRITE_HV(bf) do { *(bf16x8*)(V_lds + (bf) * SHM_V + vst0) = S.st_v0; *(bf16x8*)(V_lds + (bf) * SHM_V + vst1) = S.st_v1; } while (0)
#define SWRITE_H(bf) do { SWRITE_HV(bf); SWRITE_HK(bf); } while (0)
#define SLOAD_F(p, k0) do { S.sf0 = *(const f32x4*)ROW(p, k0, sr); S.sf1 = *(const f32x4*)(ROW(p, k0, sr) + 4);                \
                            S.sf2 = *(const f32x4*)ROW(p, k0, 32 + sr); S.sf3 = *(const f32x4*)(ROW(p, k0, 32 + sr) + 4); } while (0)
#define SWRITE_KF(bf) do { *(bf16x8*)(K_lds + (bf) * SHM_K + kws) = pack8(S.sf0, S.sf1); *(bf16x8*)(K_lds + (bf) * SHM_K + kws + 32 * 256) = pack8(S.sf2, S.sf3); } while (0)
#define SWRITE_VF(bf) do { *(bf16x8*)(V_lds + (bf) * SHM_V + vst0) = pack8(S.sf0, S.sf1); *(bf16x8*)(V_lds + (bf) * SHM_V + vst1) = pack8(S.sf2, S.sf3); } while (0)
template <class TIn, class TOut>
__device__ __forceinline__ void causal_swa_prime(const BlockRef<TIn, TOut>& cur, int W, char* lds, Seam<TIn>& S, const int wv) {
    constexpr bool F32 = same_t<TIn, float>::v;
    const int tid = tid_of(wv), wid = __builtin_amdgcn_readfirstlane(tid >> 6), lane = tid & 63, r32 = lane & 31, hi = lane >> 5;
    const int sr = tid >> 4, sc = (tid & 15) * 8, kws = KSWZ(sr, sc * 2); char* K_lds = lds + 2 * SHM_V;
    const int kb0 = swa_jlo(cur.P0, W) * KVBLK;
    for (int d0 = 0; d0 < 8; ++d0) S.qr[d0] = load8<TIn>(cur.Q + (unsigned)((wid * QBLK + r32) * LD + d0 * 16 + hi * 8));
    if constexpr (F32) { SLOAD_F((const float*)cur.K, kb0); VMW(); SWRITE_KF(0); SBAR(); SLOAD_F((const float*)cur.V, kb0); }
    else { SLOAD_H(cur.K, cur.V, kb0); VMW(); SWRITE_HK(0); }
    __syncthreads();
}
template <class TIn, class TOut>
__device__ __forceinline__ void causal_swa_block(const BlockRef<TIn, TOut>& cur, const BlockRef<TIn, TOut>& nxt, int skv, int W, char* lds, Seam<TIn>& S, const __attribute__((address_space(3))) unsigned char* rowmask, const int wv) {
    constexpr bool F32 = same_t<TIn, float>::v;
    const int tid = tid_of(wv), wid = __builtin_amdgcn_readfirstlane(tid >> 6), lane = tid & 63, r32 = lane & 31, hi = lane >> 5;
    const int j_lo = swa_jlo(cur.P0, W);
    int j_hi = (cur.P0 + QB - 1) / KVBLK + 1; if (j_hi > skv / KVBLK) j_hi = skv / KVBLK;
    const int NT = j_hi - j_lo;
    const int kbn = swa_jlo(nxt.P0, W) * KVBLK;
    const int qlo = cur.P0 + wid * QBLK, qm = qlo + r32 - 4 * hi;
    char* V_lds = lds; char* K_lds = lds + 2 * SHM_V;
    float* ws = (float*)(lds + 2 * SHM_V + 2 * SHM_K) + wid * 64; float* li_l = ws, * al_l = ws + 32;
    float m_reg = -1e30f, l_reg = 0; f32x16 o[4] = {};
    const int sr = tid >> 4, sc = (tid & 15) * 8, vst0 = v_st(sr, sc), vst1 = v_st(32 + sr, sc), kws = KSWZ(sr, sc * 2);
    const int vb0 = (int)(uintptr_t)V_lds + v_rd_base(lane);
    const TIn* Kh = cur.K; const TIn* Vh = cur.V;
#define RESC(a) do { if (__any((a) < 1.f)) { if (hi == 0) al_l[r32] = (a); asm volatile("s_waitcnt lgkmcnt(0)" ::: "memory");              \
                     for (int d_ = 0; d_ < 4; ++d_) for (int r = 0; r < 16; ++r) o[d_][r] *= al_l[crow(r, hi)]; } } while (0)
#define KBASE(t) ((j_lo + (t)) * KVBLK)
#define ACT(t) (KBASE(t) <= qlo + QBLK - 1 && KBASE(t) + KVBLK - 1 >= qlo - W + 1)
#define MASKT(P0_, P1_, t) do { const int kb_ = KBASE(t); \
        if (kb_ < cur.P0) { const bool keep_ = (((unsigned)rowmask[wid * QBLK + r32] >> (kb_ >> 8)) & 1u) != 0u; if (!__all(keep_)) { const float NEG_ = -__builtin_inff(); \
            _Pragma("unroll") for (int r_ = 0; r_ < 16; ++r_) { P0_[r_] = keep_ ? P0_[r_] : NEG_; P1_[r_] = keep_ ? P1_[r_] : NEG_; } } } \
        else if (kb_ + KVBLK - 1 > qlo) mask_tile(P0_, P1_, qm - kb_, (unsigned)W); } while (0)
    constexpr int NQL = F32 ? 16 : 8;
    constexpr bool SK = WSKIP && !F32;
#define SEAM_K0() do { VMWN(NQL); if constexpr (F32) { SWRITE_KF(0); SBAR(); SLOAD_F((const float*)nxt.V, kbn); } else { SWRITE_HK(0); } SBAR(); } while (0)
    f32x16 pA0, pA1, pB0, pB1; float mnA, mnB, alA, alB; bf16x8 pa0, pa1, pa2, pa3;
    if constexpr (F32) { VMW(); SWRITE_VF(0); SBAR(); } else { SWRITE_HV(0); SBAR(); }
    if (NT > 1) { if constexpr (F32) SLOAD_F((const float*)Kh, KBASE(1)); else SLOAD_H(Kh, Vh, KBASE(1)); }
    SBAR(); qkt<0, SK>(pA0, pA1, K_lds, r32, hi, S.qr, ACT(0));
    if constexpr (F32) { if (NT > 1) { VMW(); SWRITE_KF(1); SBAR(); SLOAD_F((const float*)Vh, KBASE(1)); } }
    MASKT(pA0, pA1, 0); partialSM(pA0, pA1, m_reg, mnA, alA);
    if (NT > 1) { VMW(); if constexpr (F32) { SWRITE_VF(1); SBAR(); if (NT > 2) SLOAD_F((const float*)Kh, KBASE(2)); } else SWRITE_H(1); }
    __syncthreads();
#define HALF_STEP(PX0, PX1, mnX, alX, PY0, PY1, alY, t, KB, VB, SB) do {                                                      \
        SBAR(); qkt<KB, SK>(PX0, PX1, K_lds, r32, hi, S.qr, ACT(t));                                             \
        finishSM(PY0, PY1, alY, l_reg, pa0, pa1, pa2, pa3); SBAR();                                                           \
        if ((t) + 1 < NT) { if constexpr (F32) { VMW(); SWRITE_KF(SB); SBAR(); SLOAD_F((const float*)Vh, KBASE((t) + 1)); }  \
                            else { SLOAD_H(Kh, Vh, KBASE((t) + 1)); } SBAR(); }                                               \
        pv_tile<VB, SK>(o, vb0, pa0, pa1, pa2, pa3, ACT((t) - 1)); MASKT(PX0, PX1, (t)); partialSM(PX0, PX1, m_reg, mnX, alX);                                        \
        __syncthreads();                                                                                                      \
        if ((t) + 1 < NT) { VMW(); if constexpr (F32) { SWRITE_VF(SB); SBAR(); if ((t) + 2 < NT) SLOAD_F((const float*)Kh, KBASE((t) + 2)); } \
                            else { SWRITE_H(SB); } }                                                                          \
        RESC(alX); __syncthreads(); } while (0)
    for (int t = 1; t + 1 < NT; t += 2) {
        HALF_STEP(pB0, pB1, mnB, alB, pA0, pA1, alA, t, 1, 0, 0);
        HALF_STEP(pA0, pA1, mnA, alA, pB0, pB1, alB, t + 1, 0, 1, 1);
    }
    const bool even = (NT & 1) == 0;
    if (even) { SBAR(); qkt<1, SK>(pB0, pB1, K_lds, r32, hi, S.qr, ACT(NT - 1)); SBAR(); }
#define QROW(e) (nxt.Q + (size_t)(wid * QBLK + r32) * LD + ((e) >> 1) * 16 + hi * 8 + ((e) & 1) * 4)
    if constexpr (F32) { SLOAD_F((const float*)nxt.K, kbn); SBAR();
#pragma unroll
        for (int e = 0; e < 8; ++e) S.tq[e] = *(const f32x4*)QROW(e); }
    else { SLOAD_H(nxt.K, nxt.V, kbn); SBAR();
#pragma unroll
        for (int d0 = 0; d0 < 8; ++d0) S.qr[d0] = load8<TIn>(nxt.Q + (unsigned)((wid * QBLK + r32) * LD + d0 * 16 + hi * 8)); }
    SBAR();
    finishSM(pA0, pA1, alA, l_reg, pa0, pa1, pa2, pa3); SBAR();
    if constexpr (F32) {
#pragma unroll
        for (int e = 8; e < 16; ++e) S.tq[e] = *(const f32x4*)QROW(e); SBAR(); }
#undef QROW
    pv_tile<0, SK>(o, vb0, pa0, pa1, pa2, pa3, ACT(even ? NT - 2 : NT - 1));
    if (even) { MASKT(pB0, pB1, NT - 1); partialSM(pB0, pB1, m_reg, mnB, alB); __syncthreads(); RESC(alB);
        finishSM(pB0, pB1, alB, l_reg, pa0, pa1, pa2, pa3); SBAR(); pv_tile<1, SK>(o, vb0, pa0, pa1, pa2, pa3, ACT(NT - 1)); }
    SBAR(); SEAM_K0();
    if (hi == 0) li_l[r32] = l_reg; asm volatile("s_waitcnt lgkmcnt(0)" ::: "memory");
    float rli[16];
#pragma unroll
    for (int r = 0; r < 16; ++r) rli[r] = __builtin_amdgcn_rcpf(li_l[crow(r, hi)]);
    TOut* Ow = cur.O + (size_t)(wid * QBLK) * LD;
#pragma unroll
    for (int r = 0; r < 16; ++r) { const int orow = crow(r, hi);
#pragma unroll
        for (int d0 = 0; d0 < 4; ++d0) { const float v = o[d0][r] * rli[r];
            if constexpr (same_t<TOut, float>::v) { Ow[(size_t)orow * LD + d0 * 32 + r32] = v; }
            else { const float vn = __shfl_xor(v, 1);
                   if ((r32 & 1) == 0) *(unsigned*)(Ow + (unsigned)(orow * LD + d0 * 32 + r32)) = cvtpk(v, vn); } } }
    if constexpr (F32) {
#pragma unroll
        for (int d0 = 0; d0 < 8; ++d0) S.qr[d0] = pack8(S.tq[2 * d0], S.tq[2 * d0 + 1]); }
    __syncthreads();
#undef RESC
#undef KBASE
#undef ACT
#undef MASKT
#undef SEAM_K0
#undef HALF_STEP
}
#undef ROW
#undef VMW
#undef VMWN
#undef SLOAD_H
#undef SWRITE_HK
#undef SWRITE_HV
#undef SWRITE_H
#undef SLOAD_F
#undef SWRITE_KF
#undef SWRITE_VF

}

constexpr int NB = 4, SEQ = 2048, DM = 4096, M = NB * SEQ;
constexpr int NH = 16, HD = 128, AW = 2048, LW = 2048, FF = 11008, INC = 18432;
constexpr int MOBA_BLK = 256, MOBA_TOPK = 3;
constexpr float EPS = 1e-6f;

constexpr size_t MiB = 1u << 20;
constexpr size_t WS_CTL = 0, CTL_ZERO_BYTES = 1 * MiB;
constexpr size_t WS_ROPE = 1 * MiB;
constexpr size_t WS_KM = 2 * MiB;
constexpr size_t WS_SP = 2 * MiB + 512 * 1024;
constexpr size_t WS_RS = 2 * MiB + 512 * 1024 + 64 * 1024;
constexpr size_t WS_WGU1 = 8 * MiB;
constexpr size_t WS_WD1 = WS_WGU1 + 172 * MiB;
constexpr size_t WS_WIN = WS_WD1 + 86 * MiB;
constexpr size_t WS_WAO = WS_WIN + 144 * MiB;
constexpr size_t WS_WRO = WS_WAO + 16 * MiB;
constexpr size_t WS_WO = WS_WRO + 16 * MiB;
constexpr size_t WS_WGU2 = WS_WO + 32 * MiB;
constexpr size_t WS_WD2 = WS_WGU2 + 172 * MiB;
constexpr size_t WS_ACT = WS_WD2 + 86 * MiB;
constexpr size_t WS_H = WS_ACT + 64 * MiB;
constexpr size_t WS_F = WS_H + 172 * MiB;
constexpr size_t WS_XR = WS_F + 128 * MiB;
constexpr size_t WS_MG = WS_XR + 128 * MiB;
constexpr size_t WS_END = WS_MG + 64 * MiB;
static_assert(WS_END <= 1500 * MiB, "workspace map");
constexpr int CW_BAR = 4096;

constexpr int RING_OFF = 0, RING_BYTES = 131072;
constexpr int MISC_OFF = RING_BYTES;
constexpr int LDS_BYTES = 147456;
constexpr int NWAVES = 8, NTHR = 512;

#define GAS __attribute__((address_space(1)))
#define LAS __attribute__((address_space(3)))
typedef unsigned short bf16;
typedef unsigned v4u __attribute__((ext_vector_type(4)));
typedef unsigned v2u __attribute__((ext_vector_type(2)));
typedef float f32x4 __attribute__((ext_vector_type(4)));
typedef float f32x2 __attribute__((ext_vector_type(2)));
#define LDS_WAIT() asm volatile("s_waitcnt lgkmcnt(0)" ::: "memory")
#define VM_WAIT() asm volatile("s_waitcnt vmcnt(0)" ::: "memory")
__device__ __forceinline__ unsigned f2bf(float f) { unsigned u = __builtin_bit_cast(unsigned, f); return (u + 0x7fffu + ((u >> 16) & 1u)) >> 16; }
__device__ __forceinline__ unsigned pk2(float lo, float hi) { return f2bf(lo) | (f2bf(hi) << 16); }
__device__ __forceinline__ float bflo(unsigned w) { return __builtin_bit_cast(float, w << 16); }
__device__ __forceinline__ float bfhi(unsigned w) { return __builtin_bit_cast(float, w & 0xffff0000u); }
__device__ __forceinline__ float sigmoidf_(float x) { return __builtin_amdgcn_rcpf(1.f + __expf(-x)); }
__device__ __forceinline__ float gelu_tanh(float x) { const float z = 1.5957691216057308f * (x + 0.044715f * x * x * x); return x * sigmoidf_(z); }
__device__ __forceinline__ float one_minus_exp(float x) {
    const float p = -x * (1.f + x * (0.5f + x * (0.16666667f + x * (0.041666668f + x * (0.0083333338f + x * 0.0013888889f)))));
    return x > -0.3f ? p : 1.f - __expf(x);
}
__device__ __forceinline__ float wave_sum(float v) {
#pragma unroll
    for (int o = 1; o < 64; o <<= 1) v += __shfl_xor(v, o);
    return v;
}
__device__ __forceinline__ float wave_max(float v) {
#pragma unroll
    for (int o = 1; o < 64; o <<= 1) v = fmaxf(v, __shfl_xor(v, o));
    return v;
}

#define XB_TMO      128
#define XB_XCNT(j)  (256  + 64 * (j))
#define XB_XSUB(j)  (1280 + 64 * (j))
#define XB_XGEN(j)  (2304 + 64 * (j))
#define XB_TOP      3328
#define XB_TOPGEN   3392
#define XCD_BAR_WORDS 3456
#define XB_SPIN_CAP (1u << 18)
__device__ __forceinline__ unsigned xb_ld(unsigned* p)              { return __hip_atomic_load(p, __ATOMIC_RELAXED, __HIP_MEMORY_SCOPE_AGENT); }
__device__ __forceinline__ unsigned xb_add(unsigned* p, unsigned v) { return __hip_atomic_fetch_add(p, v, __ATOMIC_RELAXED, __HIP_MEMORY_SCOPE_AGENT); }
__device__ __forceinline__ unsigned xb_xcc_id() { return (unsigned)__builtin_amdgcn_s_getreg((3 << 11) | 20) & 0xFu; }
#define XB_SPIN(cond, bar) do { unsigned _sp = 0; while (cond) { __builtin_amdgcn_s_sleep(1); \
    if ((++_sp & 255u) == 0u) { if (xb_ld(&(bar)[XB_TMO])) break; if (_sp > XB_SPIN_CAP) { atomicAdd(&(bar)[XB_TMO], 1u); break; } } } } while (0)
struct XcdBarrier { unsigned* bar; unsigned x; volatile LAS unsigned* st; int wv; };
__device__ __forceinline__ XcdBarrier xcd_barrier_post(unsigned* bar, volatile LAS unsigned* st, int wv) {
    XcdBarrier b; b.bar = bar; b.x = xb_xcc_id(); b.st = st; b.wv = wv;
    if (tid_of(wv) == 0) (void)xb_add(&bar[XB_XCNT(b.x)], 1u);
    return b;
}
__device__ __forceinline__ void xcd_barrier_complete(unsigned* bar, unsigned x, unsigned& nloc, unsigned& nx) {
    const unsigned G = gridDim.x * gridDim.y * gridDim.z;
    unsigned sum, cnt, mine, sp = 0u;
    for (;;) {
        sum = 0u; cnt = 0u; mine = 0u;
#pragma unroll
        for (unsigned j = 0; j < 16; ++j) { const unsigned c = xb_ld(&bar[XB_XCNT(j)]); sum += c; cnt += (c > 0u) ? 1u : 0u; mine = (j == x) ? c : mine; }
        if (sum == G) break;
        __builtin_amdgcn_s_sleep(1);
        if ((++sp & 255u) == 0u) { if (xb_ld(&bar[XB_TMO])) break; if (sp > XB_SPIN_CAP) { atomicAdd(&bar[XB_TMO], 1u); break; } }
    }
    nloc = mine > 0u ? mine : 1u; nx = cnt > 0u ? cnt : 1u;
}
__device__ __forceinline__ void xcd_barrier(const XcdBarrier& b) {
    asm volatile("s_waitcnt vmcnt(0)" ::: "memory");
    __syncthreads();
    if (tid_of(b.wv) == 0) {
        unsigned* bar = b.bar;
        __builtin_amdgcn_s_waitcnt(0);
        unsigned nloc = b.st[0], nx = b.st[1];
        if (nloc == 0u) { xcd_barrier_complete(bar, b.x, nloc, nx); b.st[0] = nloc; b.st[1] = nx; }
        const unsigned old = xb_add(&bar[XB_XSUB(b.x)], 1u);
        const unsigned gen = old / nloc;
        if (old + 1u == (gen + 1u) * nloc) {
            __builtin_amdgcn_fence(__ATOMIC_RELEASE, "agent");
            asm volatile("s_waitcnt vmcnt(0)" ::: "memory");
            const unsigned og = xb_add(&bar[XB_TOP], 1u);
            const unsigned tg = og / nx;
            if (og + 1u == (tg + 1u) * nx) xb_add(&bar[XB_TOPGEN], 1u);
            else XB_SPIN(xb_ld(&bar[XB_TOPGEN]) == tg, bar);
            __builtin_amdgcn_fence(__ATOMIC_ACQUIRE, "agent");
            xb_add(&bar[XB_XGEN(b.x)], 1u);
            asm volatile("s_waitcnt vmcnt(0)" ::: "memory");
        } else {
            XB_SPIN(xb_ld(&bar[XB_XGEN(b.x)]) == gen, bar);
            __builtin_amdgcn_fence(__ATOMIC_ACQUIRE, "agent");
            asm volatile("s_waitcnt vmcnt(0)" ::: "memory");
        }
    }
    __syncthreads();
}

using pg8::Unit; using pg8::HALF; using pg8::BM; using pg8::cvt_pk_bf16;
typedef pg8::f32x4 (AccT)[2][2][4][2];

constexpr float WGI_SCALE = 2111.f;
__device__ __forceinline__ unsigned pk4_i8(float a, float b, float c, float d) {
    unsigned w = __builtin_amdgcn_cvt_pk_u8_f32(a + 128.f, 0, 0u); w = __builtin_amdgcn_cvt_pk_u8_f32(b + 128.f, 1, w);
    w = __builtin_amdgcn_cvt_pk_u8_f32(c + 128.f, 2, w); w = __builtin_amdgcn_cvt_pk_u8_f32(d + 128.f, 3, w); return w ^ 0x80808080u; }
constexpr int F8T = 48;
constexpr float X8_SCALE = 32.f, WG8_SCALE = 64.f;
constexpr float H8_SCALE = 8.f, W8_SCALE = 128.f;
__device__ __forceinline__ unsigned pk4_fp8(float a, float b, float c, float d) {
    int w = __builtin_amdgcn_cvt_pk_fp8_f32(a, b, 0, false); w = __builtin_amdgcn_cvt_pk_fp8_f32(c, d, w, true); return (unsigned)w; }
constexpr float HQ_SCALE = 127.f / (5.f * 5.656854f * 0.6f);
constexpr float WQ_SCALE = 127.f / (3.85f * 5.656854f * 0.0095311f);
constexpr float DQ_SCALE = 1.f / (HQ_SCALE * WQ_SCALE * 32.f);
template <int HF, bool RSV = true, bool IACC = false>
struct EpiSwiGLU {
    static constexpr bool PERM = true, HAS_RS = RSV;
    bf16* H; const float* RSc; float sc;
    __device__ __forceinline__ void load_rs(const Unit& u, int wr, int fr, float (&rsv)[8]) const {
#pragma unroll
        for (int i = 0; i < 8; ++i) rsv[i] = RSc[u.pm * BM + wr * 64 + fr + (i >> 2) * HALF + (i & 3) * 16] * sc; }
    __device__ __forceinline__ void operator()(AccT& acc, const Unit& u, int wr, int wc, int fr, int fq) const {
        const float rsc[8] = {sc, sc, sc, sc, sc, sc, sc, sc}; (*this)(acc, u, wr, wc, fr, fq, rsc); }
    __device__ __forceinline__ void operator()(AccT& acc, const Unit& u, int wr, int wc, int fr, int fq, const float (&rsv)[8]) const {
        const int row0 = u.pm * BM + wr * 64 + fr, col0 = u.pn * HALF + wc * 32 + 8 * fq;
#pragma unroll
        for (int ai = 0; ai < 2; ++ai)
#pragma unroll
            for (int m = 0; m < 4; ++m) {
                float o[8]; const float rs = rsv[ai * 4 + m];
                if constexpr (HF == 2) {
                    typedef float f2 __attribute__((ext_vector_type(2)));
                    f2 p[4]; const float rsq = rs * HQ_SCALE;
#pragma unroll
                    for (int n = 0; n < 2; ++n)
#pragma unroll
                        for (int h = 0; h < 2; ++h) { const float g0 = acc[ai][0][m][n][2 * h], g1 = acc[ai][0][m][n][2 * h + 1], u0 = acc[ai][1][m][n][2 * h], u1 = acc[ai][1][m][n][2 * h + 1];
                            const f2 gi = IACC ? (f2){(float)__float_as_int(g0), (float)__float_as_int(g1)} : (f2){g0, g1}, ui = IACC ? (f2){(float)__float_as_int(u0), (float)__float_as_int(u1)} : (f2){u0, u1};
                            const f2 gt = gi * rs, up = ui * rsq, ex = gt * -1.4426950408889634f;
                            const f2 den = (f2){__builtin_amdgcn_exp2f(ex.x), __builtin_amdgcn_exp2f(ex.y)} + 1.f;
                            const f2 sg = (f2){__builtin_amdgcn_rcpf(den.x), __builtin_amdgcn_rcpf(den.y)};
                            p[2 * n + h] = gt * sg * up; }
#pragma unroll
                    for (int i = 0; i < 4; ++i) p[i] = (f2){p[i].x + p[i].y, p[i].x - p[i].y};
                    { const f2 t0 = p[0], t2 = p[2]; p[0] = t0 + p[1]; p[1] = t0 - p[1]; p[2] = t2 + p[3]; p[3] = t2 - p[3]; }
                    { const f2 t0 = p[0], t1 = p[1]; p[0] = t0 + p[2]; p[2] = t0 - p[2]; p[1] = t1 + p[3]; p[3] = t1 - p[3]; }
                    { const float s16 = (fq & 1) ? -1.f : 1.f, s32 = (fq & 2) ? -1.f : 1.f;
#pragma unroll
                      for (int i = 0; i < 4; ++i) { const auto r0 = __builtin_amdgcn_permlane16_swap(__float_as_uint(p[i].x), __float_as_uint(p[i].x), false, false), r1 = __builtin_amdgcn_permlane16_swap(__float_as_uint(p[i].y), __float_as_uint(p[i].y), false, false);
                          p[i] = (f2){__uint_as_float(r0[0]), __uint_as_float(r1[0])} + (f2){__uint_as_float(r0[1]), __uint_as_float(r1[1])} * s16; }
#pragma unroll
                      for (int i = 0; i < 4; ++i) { const auto r0 = __builtin_amdgcn_permlane32_swap(__float_as_uint(p[i].x), __float_as_uint(p[i].x), false, false), r1 = __builtin_amdgcn_permlane32_swap(__float_as_uint(p[i].y), __float_as_uint(p[i].y), false, false);
                          p[i] = (f2){__uint_as_float(r0[0]), __uint_as_float(r1[0])} + (f2){__uint_as_float(r0[1]), __uint_as_float(r1[1])} * s32; } }
                    v2u w; w.x = pk4_i8(p[0].x, p[0].y, p[1].x, p[1].y); w.y = pk4_i8(p[2].x, p[2].y, p[3].x, p[3].y);
                    *(v2u*)((unsigned char*)H + (size_t)(row0 + ai * HALF + m * 16) * FF + col0) = w;
                    continue; }
#pragma unroll
                for (int n = 0; n < 2; ++n)
#pragma unroll
                    for (int j = 0; j < 4; ++j) { const float gf = acc[ai][0][m][n][j], uf = acc[ai][1][m][n][j];
                        const float ga = IACC ? (float)__float_as_int(gf) : gf, ua = IACC ? (float)__float_as_int(uf) : uf;
                        const float gt = ga * rs, up = ua * rs; o[4 * n + j] = gt * sigmoidf_(gt) * up; }
                if constexpr (HF == 2) {
#define HAD_BF(a, b) do { const float t_ = a; a = t_ + b; b = t_ - b; } while (0)
                    HAD_BF(o[0], o[1]); HAD_BF(o[2], o[3]); HAD_BF(o[4], o[5]); HAD_BF(o[6], o[7]);
                    HAD_BF(o[0], o[2]); HAD_BF(o[1], o[3]); HAD_BF(o[4], o[6]); HAD_BF(o[5], o[7]);
                    HAD_BF(o[0], o[4]); HAD_BF(o[1], o[5]); HAD_BF(o[2], o[6]); HAD_BF(o[3], o[7]);
#undef HAD_BF
                    { const float s16 = (fq & 1) ? -1.f : 1.f, s32 = (fq & 2) ? -1.f : 1.f;
#pragma unroll
                      for (int e = 0; e < 8; ++e) { const auto r = __builtin_amdgcn_permlane16_swap(__float_as_uint(o[e]), __float_as_uint(o[e]), false, false); o[e] = __uint_as_float(r[0]) + s16 * __uint_as_float(r[1]); }
#pragma unroll
                      for (int e = 0; e < 8; ++e) { const auto r = __builtin_amdgcn_permlane32_swap(__float_as_uint(o[e]), __float_as_uint(o[e]), false, false); o[e] = __uint_as_float(r[0]) + s32 * __uint_as_float(r[1]); } }
                    v2u w; w.x = pk4_i8(o[0] * HQ_SCALE, o[1] * HQ_SCALE, o[2] * HQ_SCALE, o[3] * HQ_SCALE); w.y = pk4_i8(o[4] * HQ_SCALE, o[5] * HQ_SCALE, o[6] * HQ_SCALE, o[7] * HQ_SCALE);
                    *(v2u*)((unsigned char*)H + (size_t)(row0 + ai * HALF + m * 16) * FF + col0) = w;
                } else if constexpr (HF == 1) {
#pragma unroll
                    for (int e = 0; e < 8; ++e) o[e] = __builtin_amdgcn_fmed3f(o[e] * H8_SCALE, -448.f, 448.f);
                    v2u w; w.x = pk4_fp8(o[0], o[1], o[2], o[3]); w.y = pk4_fp8(o[4], o[5], o[6], o[7]);
                    *(v2u*)((unsigned char*)H + (size_t)(row0 + ai * HALF + m * 16) * FF + col0) = w;
                } else {
                    v4u w; w.x = cvt_pk_bf16(o[0], o[1]); w.y = cvt_pk_bf16(o[2], o[3]); w.z = cvt_pk_bf16(o[4], o[5]); w.w = cvt_pk_bf16(o[6], o[7]);
                    *(v4u*)(H + (size_t)(row0 + ai * HALF + m * 16) * FF + col0) = w; }
            }
    }
};
struct EpiF32 {
    static constexpr bool PERM = false, HAS_RS = false;
    bf16* C; int ldc; float sc;
    __device__ __forceinline__ void operator()(AccT& acc, const Unit& u, int wr, int wc, int fr, int fq) const {
        const int row0 = u.pm * BM + wr * 64 + fr, col0 = u.pn * BM + wc * 32 + 4 * fq;
#pragma unroll
        for (int ai = 0; ai < 2; ++ai)
#pragma unroll
            for (int m = 0; m < 4; ++m) { bf16* rowp = C + (size_t)(row0 + ai * HALF + m * 16) * ldc + col0;
#pragma unroll
                for (int bj = 0; bj < 2; ++bj)
#pragma unroll
                    for (int n = 0; n < 2; ++n) { const pg8::f32x4 a = acc[ai][bj][m][n] * sc; v2u w; w.x = cvt_pk_bf16(a[0], a[1]); w.y = cvt_pk_bf16(a[2], a[3]); *(v2u*)(rowp + bj * HALF + n * 16) = w; } }
    }
};
struct EpiF32I {
    static constexpr bool PERM = false, HAS_RS = false;
    bf16* C; int ldc; float sc;
    __device__ __forceinline__ void operator()(AccT& acc, const Unit& u, int wr, int wc, int fr, int fq) const {
        const int row0 = u.pm * BM + wr * 64 + fr, col0 = u.pn * BM + wc * 32 + 4 * fq;
#pragma unroll
        for (int ai = 0; ai < 2; ++ai)
#pragma unroll
            for (int m = 0; m < 4; ++m) { bf16* rowp = C + (size_t)(row0 + ai * HALF + m * 16) * ldc + col0;
#pragma unroll
                for (int bj = 0; bj < 2; ++bj)
#pragma unroll
                    for (int n = 0; n < 2; ++n) { const pg8::f32x4 a = acc[ai][bj][m][n]; const float a0 = a[0], a1 = a[1], a2 = a[2], a3 = a[3];
                        const pg8::f32x4 f = (pg8::f32x4){(float)__float_as_int(a0), (float)__float_as_int(a1), (float)__float_as_int(a2), (float)__float_as_int(a3)} * sc;
                        v2u w; w.x = cvt_pk_bf16(f[0], f[1]); w.y = cvt_pk_bf16(f[2], f[3]);
                        *(v2u*)(rowp + bj * HALF + n * 16) = w; } }
    }
};
struct EpiProj {
    static constexpr bool PERM = true, HAS_RS = true;
    bf16* QKVX; bf16* SAB; const float* CS; const float* SN; float* KM; const float* RSc;
    __device__ __forceinline__ void store8(bf16* p, const float (&o)[8]) const {
        v4u w; w.x = cvt_pk_bf16(o[0], o[1]); w.y = cvt_pk_bf16(o[2], o[3]); w.z = cvt_pk_bf16(o[4], o[5]); w.w = cvt_pk_bf16(o[6], o[7]); *(v4u*)p = w; }
    __device__ __forceinline__ void load_rs(const Unit& u, int wr, int fr, float (&rsv)[8]) const {
#pragma unroll
        for (int i = 0; i < 8; ++i) rsv[i] = RSc[u.pm * BM + wr * 64 + fr + (i >> 2) * HALF + (i & 3) * 16]; }
    __device__ __forceinline__ void operator()(AccT& acc, const Unit& u, int wr, int wc, int fr, int fq, const float (&rsv)[8]) const {
        const int row0 = u.pm * BM + wr * 64 + fr, cw = wc * 32 + 8 * fq, pn = u.pn;
#pragma unroll
        for (int ai = 0; ai < 2; ++ai)
#pragma unroll
            for (int m = 0; m < 4; ++m) { const float rs = rsv[ai * 4 + m];
#pragma unroll
                for (int bj = 0; bj < 2; ++bj)
#pragma unroll
                    for (int n = 0; n < 2; ++n) acc[ai][bj][m][n] *= rs; }
        if (pn < 16) {
            bf16* dst = QKVX + (size_t)(pn >> 3) * ((size_t)M * AW); const int pr = pn & 7; const bool isk = pn >= 8;
            f32x4 ks[2][2];
#pragma unroll
            for (int bj = 0; bj < 2; ++bj)
#pragma unroll
                for (int n = 0; n < 2; ++n) ks[bj][n] = (f32x4){0.f, 0.f, 0.f, 0.f};
#pragma unroll
            for (int ai = 0; ai < 2; ++ai) {
                f32x4 csv[4], snv[4];
#pragma unroll
                for (int m = 0; m < 4; ++m) { const int s = (row0 + ai * HALF + m * 16) & (SEQ - 1);
                    csv[m] = *(const f32x4*)(CS + s * 64 + wc * 16 + 4 * fq); snv[m] = *(const f32x4*)(SN + s * 64 + wc * 16 + 4 * fq); }
#pragma unroll
                for (int m = 0; m < 4; ++m) { const int row = row0 + ai * HALF + m * 16; const f32x4 cs = csv[m], sn = snv[m];
#pragma unroll
                    for (int bj = 0; bj < 2; ++bj) { const f32x4 t1 = acc[ai][bj][m][0], t2 = acc[ai][bj][m][1];
                        const f32x4 o1 = t1 * cs - t2 * sn, o2 = t2 * cs + t1 * sn;
                        ks[bj][0] += o1; ks[bj][1] += o2;
                        float o[8] = {o1[0], o1[1], o1[2], o1[3], o2[0], o2[1], o2[2], o2[3]};
                        store8(dst + (size_t)row * AW + (pr * 2 + bj) * HD + cw, o); } }
                asm volatile("" ::: "memory"); }
            if (isk) {
#pragma unroll
                for (int bj = 0; bj < 2; ++bj)
#pragma unroll
                    for (int n = 0; n < 2; ++n) { f32x4 v = ks[bj][n];
#pragma unroll
                        for (int o = 1; o < 16; o <<= 1) { v[0] += __shfl_xor(v[0], o); v[1] += __shfl_xor(v[1], o); v[2] += __shfl_xor(v[2], o); v[3] += __shfl_xor(v[3], o); }
                        if (fr == 0) *(f32x4*)(KM + ((size_t)wr * 32 + u.pm) * AW + (pr * 2 + bj) * HD + cw + 4 * n) = v; }
            }
        } else if (pn < 40) {
            const int t = (pn - 16) >> 3, pr = pn & 7; bf16* dst = QKVX + (size_t)(pn >> 3) * ((size_t)M * AW);
#pragma unroll
            for (int ai = 0; ai < 2; ++ai)
#pragma unroll
                for (int m = 0; m < 4; ++m) { const int row = row0 + ai * HALF + m * 16;
#pragma unroll
                    for (int bj = 0; bj < 2; ++bj) { float o[8];
#pragma unroll
                        for (int n = 0; n < 2; ++n)
#pragma unroll
                            for (int j = 0; j < 4; ++j) { const float x = acc[ai][bj][m][n][j]; o[4 * n + j] = (t == 2) ? gelu_tanh(x) : x; }
                        store8(dst + (size_t)row * AW + pr * BM + bj * HALF + cw, o); } }
        } else {
            const int pr = (pn - 40) & 15; bf16* dst = SAB + (size_t)((pn - 40) >> 4) * ((size_t)M * DM);
#pragma unroll
            for (int ai = 0; ai < 2; ++ai)
#pragma unroll
                for (int m = 0; m < 4; ++m) { const int row = row0 + ai * HALF + m * 16;
#pragma unroll
                    for (int bj = 0; bj < 2; ++bj) { float o[8];
#pragma unroll
                        for (int n = 0; n < 2; ++n)
#pragma unroll
                            for (int j = 0; j < 4; ++j) o[4 * n + j] = sigmoidf_(acc[ai][bj][m][n][j]);
                        store8(dst + (size_t)row * DM + pr * BM + bj * HALF + cw, o); } }
        }
    }
};
constexpr int F1T = 86;
typedef float f2v __attribute__((ext_vector_type(2)));
constexpr int I8A0 = 0, I8A1 = 24, I8B0 = 40;
constexpr int GATE_PN0 = 40;
struct EpiGate {
    static constexpr bool PERM = true, HAS_RS = true;
    bf16* SAB; const float* RSc; float sc; bf16* QKVX;
    __device__ __forceinline__ void load_rs(const Unit& u, int wr, int fr, float (&rsv)[8]) const {
#pragma unroll
        for (int i = 0; i < 8; ++i) rsv[i] = RSc[u.pm * BM + wr * 64 + fr + (i >> 2) * HALF + (i & 3) * 16] * sc; }
    __device__ __forceinline__ void operator()(AccT& acc, const Unit& u, int wr, int wc, int fr, int fq, const float (&rsv)[8]) const {
        const int row0 = u.pm * BM + wr * 64 + fr, cw = wc * 32 + 8 * fq, pn = u.pn;
        if (pn < GATE_PN0) {
            const int t = (pn - 16) >> 3, pr8 = pn & 7; bf16* dq = QKVX + (size_t)(pn >> 3) * ((size_t)M * AW);
#pragma unroll
            for (int ai = 0; ai < 2; ++ai)
#pragma unroll
                for (int m = 0; m < 4; ++m) { const int row = row0 + ai * HALF + m * 16; const float rs = rsv[ai * 4 + m];
#pragma unroll
                    for (int bj = 0; bj < 2; ++bj) { f2v o[4];
#pragma unroll
                        for (int n = 0; n < 2; ++n)
#pragma unroll
                            for (int h = 0; h < 2; ++h) { const float a0 = acc[ai][bj][m][n][2 * h], a1 = acc[ai][bj][m][n][2 * h + 1];
                                const f2v x = (f2v){(float)__float_as_int(a0), (float)__float_as_int(a1)} * rs; o[2 * n + h] = (t == 2) ? (f2v){gelu_tanh(x.x), gelu_tanh(x.y)} : x; }
                        v4u w; w.x = cvt_pk_bf16(o[0].x, o[0].y); w.y = cvt_pk_bf16(o[1].x, o[1].y); w.z = cvt_pk_bf16(o[2].x, o[2].y); w.w = cvt_pk_bf16(o[3].x, o[3].y);
                        *(v4u*)(dq + (size_t)row * AW + pr8 * BM + bj * HALF + cw) = w; } }
            return; }
        const int pr = (pn - GATE_PN0) & 15; bf16* dst = SAB + (size_t)((pn - GATE_PN0) >> 4) * ((size_t)M * DM);
#pragma unroll
        for (int ai = 0; ai < 2; ++ai)
#pragma unroll
            for (int m = 0; m < 4; ++m) { const int row = row0 + ai * HALF + m * 16; const float rs = rsv[ai * 4 + m];
#pragma unroll
                for (int bj = 0; bj < 2; ++bj) { f2v o[4]; const float rsn = rs * -1.4426950408889634f;
#pragma unroll
                    for (int n = 0; n < 2; ++n)
#pragma unroll
                        for (int h = 0; h < 2; ++h) { const float a0 = acc[ai][bj][m][n][2 * h], a1 = acc[ai][bj][m][n][2 * h + 1];
                            const f2v ex = (f2v){(float)__float_as_int(a0), (float)__float_as_int(a1)} * rsn;
                            const f2v den = (f2v){__builtin_amdgcn_exp2f(ex.x), __builtin_amdgcn_exp2f(ex.y)} + 1.f;
                            o[2 * n + h] = (f2v){__builtin_amdgcn_rcpf(den.x), __builtin_amdgcn_rcpf(den.y)}; }
                    v4u w; w.x = cvt_pk_bf16(o[0].x, o[0].y); w.y = cvt_pk_bf16(o[1].x, o[1].y); w.z = cvt_pk_bf16(o[2].x, o[2].y); w.w = cvt_pk_bf16(o[3].x, o[3].y);
                    *(v4u*)(dst + (size_t)row * DM + pr * BM + bj * HALF + cw) = w; } }
    }
};
struct EpiProjI {
    static constexpr bool PERM = true, HAS_RS = true;
    EpiProj P; const float* RSq; float sc;
    __device__ __forceinline__ void load_rs(const Unit& u, int wr, int fr, float (&rsv)[8]) const {
#pragma unroll
        for (int i = 0; i < 8; ++i) rsv[i] = RSq[u.pm * BM + wr * 64 + fr + (i >> 2) * HALF + (i & 3) * 16] * sc; }
    __device__ __forceinline__ void operator()(AccT& acc, const Unit& u, int wr, int wc, int fr, int fq, const float (&rsv)[8]) const {
#pragma unroll
        for (int ai = 0; ai < 2; ++ai)
#pragma unroll
            for (int bj = 0; bj < 2; ++bj)
#pragma unroll
                for (int m = 0; m < 4; ++m)
#pragma unroll
                    for (int n = 0; n < 2; ++n) { const pg8::f32x4 a = acc[ai][bj][m][n]; const float a0 = a[0], a1 = a[1], a2 = a[2], a3 = a[3];
                        acc[ai][bj][m][n] = (pg8::f32x4){(float)__float_as_int(a0), (float)__float_as_int(a1), (float)__float_as_int(a2), (float)__float_as_int(a3)}; }
        P(acc, u, wr, wc, fr, fq, rsv);
    }
};
struct EpiMerge {
    static constexpr bool PERM = true, HAS_RS = false;
    const bf16* SA; const bf16* SB; bf16* MG;
    __device__ __forceinline__ void operator()(AccT& acc, const Unit& u, int wr, int wc, int fr, int fq) const {
        const int row0 = u.pm * BM + wr * 64 + fr, col0 = u.pn * BM + wc * 32 + 8 * fq;
#pragma unroll
        for (int ai = 0; ai < 2; ++ai) {
            const size_t rb = (size_t)(row0 + ai * HALF) * DM + col0;
            v4u bw[4][2];
#pragma unroll
            for (int m = 0; m < 4; ++m)
#pragma unroll
                for (int bj = 0; bj < 2; ++bj) bw[m][bj] = *(const v4u*)(SB + rb + (size_t)m * 16 * DM + bj * HALF);
            if (u.seg == 0) {
                v4u aw[4][2];
#pragma unroll
                for (int m = 0; m < 4; ++m)
#pragma unroll
                    for (int bj = 0; bj < 2; ++bj) aw[m][bj] = *(const v4u*)(SA + rb + (size_t)m * 16 * DM + bj * HALF);
#pragma unroll
                for (int m = 0; m < 4; ++m)
#pragma unroll
                    for (int bj = 0; bj < 2; ++bj) {
                        const v4u b = bw[m][bj], a = aw[m][bj];
                        const float sb[8] = {bflo(b.x), bfhi(b.x), bflo(b.y), bfhi(b.y), bflo(b.z), bfhi(b.z), bflo(b.w), bfhi(b.w)};
                        const float sa[8] = {bflo(a.x), bfhi(a.x), bflo(a.y), bfhi(a.y), bflo(a.z), bfhi(a.z), bflo(a.w), bfhi(a.w)};
#pragma unroll
                        for (int n = 0; n < 2; ++n) { const pg8::f32x4 sav = (pg8::f32x4){sa[4 * n], sa[4 * n + 1], sa[4 * n + 2], sa[4 * n + 3]};
                            const pg8::f32x4 rbv = (pg8::f32x4){__builtin_amdgcn_rcpf(sb[4 * n]), __builtin_amdgcn_rcpf(sb[4 * n + 1]), __builtin_amdgcn_rcpf(sb[4 * n + 2]), __builtin_amdgcn_rcpf(sb[4 * n + 3])};
                            acc[ai][bj][m][n] = acc[ai][bj][m][n] * (sav * rbv); }
                    }
            } else {
#pragma unroll
                for (int m = 0; m < 4; ++m)
#pragma unroll
                    for (int bj = 0; bj < 2; ++bj) {
                        const v4u b = bw[m][bj];
                        const float sb[8] = {bflo(b.x), bfhi(b.x), bflo(b.y), bfhi(b.y), bflo(b.z), bfhi(b.z), bflo(b.w), bfhi(b.w)};
                        const pg8::f32x4 o0 = acc[ai][bj][m][0] * (pg8::f32x4){sb[0], sb[1], sb[2], sb[3]}, o1 = acc[ai][bj][m][1] * (pg8::f32x4){sb[4], sb[5], sb[6], sb[7]};
                        v4u w; w.x = cvt_pk_bf16(o0[0], o0[1]); w.y = cvt_pk_bf16(o0[2], o0[3]); w.z = cvt_pk_bf16(o1[0], o1[1]); w.w = cvt_pk_bf16(o1[2], o1[3]);
                        *(v4u*)(MG + rb + (size_t)m * 16 * DM + bj * HALF) = w;
                    }
            }
            asm volatile("" ::: "memory");
        }
    }
};

struct Args {
    const float* in[24];
    float* out; unsigned char* ws;
    int ph_lo, ph_hi;
};
enum { I_X = 0, I_F1PRE, I_F1G, I_F1U, I_F1D, I_F1POST, I_MIXPRE, I_WIN, I_CONVW, I_CONVB, I_RGWA, I_RGBA, I_RGWX, I_RGBX, I_LAM,
       I_WAO, I_WRO, I_WO, I_MIXPOST, I_F2PRE, I_F2G, I_F2U, I_F2D, I_F2POST };

__device__ __forceinline__ int dest_row(int mode, int c) {
    if (mode == 0) return c;
    if (mode == 1) return (c >> 7) * 256 + (c & 127);
    if (mode == 2) return (c >> 7) * 256 + 128 + (c & 127);
    if (c >= 2 * AW) return c;
    const int d = c & 127, nn = d >> 6, rem = d & 63, wc = rem >> 4, fq = (rem >> 2) & 3, j = rem & 3;
    return (c & ~127) + 32 * wc + 8 * fq + 4 * nn + j;
}
__device__ __forceinline__ void p0_transpose_item(const float* W, int K, int N, bf16* WT, int mode, LAS float* scr, int item, int lane) {
    const int nblk = N / 32, kb = item / nblk, nb = item % nblk, k0 = 64 * kb, n0 = 32 * nb;
#pragma unroll 8
    for (int i = 0; i < 32; ++i) { const int kk = 2 * i + (lane >> 5); scr[kk * 33 + (lane & 31)] = W[(size_t)(k0 + kk) * N + n0 + (lane & 31)]; }
    LDS_WAIT(); asm volatile("" ::: "memory");
    const int c = lane & 7;
#pragma unroll
    for (int j = 0; j < 4; ++j) { const int n = (lane >> 3) + 8 * j; const LAS float* s = scr + (8 * c) * 33 + n;
        v4u o; o.x = pk2(s[0 * 33], s[1 * 33]); o.y = pk2(s[2 * 33], s[3 * 33]); o.z = pk2(s[4 * 33], s[5 * 33]); o.w = pk2(s[6 * 33], s[7 * 33]);
        const int dr = dest_row(mode, n0 + n);
        *(GAS v4u*)(WT + ((size_t)(dr >> 8) * (K >> 6) + kb) * 16384 + (dr & 255) * 64 + 8 * c) = o; }
    LDS_WAIT(); asm volatile("" ::: "memory");
}
__device__ __forceinline__ void p0_transpose_item64(const float* W, int K, int N, bf16* WT, int mode, LAS float* scr_, int item, int lane) {
    LAS unsigned* scr = (LAS unsigned*)scr_;
    const int nblk = N / 64, kb = item / nblk, nb = item % nblk, k0 = 64 * kb, n0 = 64 * nb;
    const int kr = lane >> 4, nq = lane & 15;
    const float* src = W + (size_t)(k0 + 2 * kr) * N + n0 + 4 * nq;
    f32x4 v0[8], v1[8];
#pragma unroll
    for (int p = 0; p < 8; ++p) { v0[p] = *(const f32x4*)(src + (size_t)(8 * p) * N); v1[p] = *(const f32x4*)(src + (size_t)(8 * p + 1) * N); }
#pragma unroll
    for (int p = 0; p < 8; ++p)
#pragma unroll
        for (int j = 0; j < 4; ++j) scr[(4 * nq + j) * 33 + 4 * p + kr] = pg8::cvt_pk_bf16(v0[p][j], v1[p][j]);
    LDS_WAIT(); asm volatile("" ::: "memory");
    const int nr = lane >> 3, c = lane & 7;
#pragma unroll
    for (int q = 0; q < 8; ++q) { const int n = 8 * q + nr; const LAS unsigned* t = scr + n * 33 + 4 * c;
        v4u o; o.x = t[0]; o.y = t[1]; o.z = t[2]; o.w = t[3];
        const int dr = dest_row(mode, n0 + n);
        *(GAS v4u*)(WT + ((size_t)(dr >> 8) * (K >> 6) + kb) * 16384 + (dr & 255) * 64 + 8 * c) = o; }
    LDS_WAIT(); asm volatile("" ::: "memory");
}
__device__ __forceinline__ int invperm32(int x) { return 16 * ((x >> 2) & 1) + 4 * (x >> 3) + (x & 3); }
template <int NBAT, bool NTS = false>
__device__ __forceinline__ void conv_stream_items(const float* W, int N, bf16* WT, int mode, bool perm, int K, int it, int stride, int nitems, int lane, const float* gain = nullptr, int col0 = 0, int ncb = 0) {
    const int nblk = ncb ? ncb : (N >> 8);
    float v[NBAT][4][8], gk[NBAT][8];
#pragma unroll
    for (int b = 0; b < NBAT; ++b) { const int i = it + b * stride, ic = i < nitems ? i : nitems - 1, kc = ic / nblk, nbk = ic - kc * nblk;
        const float* src = W + (size_t)(8 * kc) * N + col0 + 256 * nbk + lane;
#pragma unroll
        for (int e = 0; e < 8; ++e) gk[b][e] = gain ? gain[8 * kc + e] : 1.f;
#pragma unroll
        for (int j = 0; j < 4; ++j)
#pragma unroll
            for (int e = 0; e < 8; ++e) v[b][j][e] = __builtin_nontemporal_load(src + (size_t)e * N + 64 * j); }
#pragma unroll
    for (int b = 0; b < NBAT; ++b) { const int i = it + b * stride;
        if (i < nitems) { const int kc = i / nblk, nbk = i - kc * nblk;
#pragma unroll
            for (int j = 0; j < 4; ++j) { int r = dest_row(mode, col0 + 256 * nbk + lane + 64 * j); if (perm) r = (r & ~31) + invperm32(r & 31);
                v4u o; o.x = pg8::cvt_pk_bf16(v[b][j][0] * gk[b][0], v[b][j][1] * gk[b][1]); o.y = pg8::cvt_pk_bf16(v[b][j][2] * gk[b][2], v[b][j][3] * gk[b][3]);
                o.z = pg8::cvt_pk_bf16(v[b][j][4] * gk[b][4], v[b][j][5] * gk[b][5]); o.w = pg8::cvt_pk_bf16(v[b][j][6] * gk[b][6], v[b][j][7] * gk[b][7]);
                { GAS v4u* dp = (GAS v4u*)(WT + ((((size_t)(r >> 8) * (K >> 6) + (kc >> 3)) * 8 + (kc & 7)) * 256 + (r & 255)) * 8); if constexpr (NTS) __builtin_nontemporal_store(o, dp); else *dp = o; } } } }
}
template <int NBAT, bool NTS = false>
__device__ __forceinline__ void conv_stream_items8(const float* W, int N, unsigned char* WT, int K, int it, int stride, int nitems, int lane, float wscale, int mode = 0, bool perm = false, const float* gain = nullptr, int ncb = 0, size_t tile_bytes = 0, bool i8 = false, int col0 = 0) {
    const int nblk = ncb ? ncb : (N >> 7); const size_t tb = tile_bytes ? tile_bytes : (size_t)256 * K;
    float v[NBAT][2][16], gk[NBAT][16];
#pragma unroll
    for (int b = 0; b < NBAT; ++b) { const int i = it + b * stride, ic = i < nitems ? i : nitems - 1, kc = ic / nblk, nbk = ic - kc * nblk;
        const float* src = W + (size_t)(16 * kc) * N + col0 + 128 * nbk + lane;
#pragma unroll
        for (int e = 0; e < 16; ++e) gk[b][e] = gain ? gain[16 * kc + e] * wscale : wscale;
#pragma unroll
        for (int j = 0; j < 2; ++j)
#pragma unroll
            for (int e = 0; e < 16; ++e) v[b][j][e] = __builtin_nontemporal_load(src + (size_t)e * N + 64 * j); }
#pragma unroll
    for (int b = 0; b < NBAT; ++b) { const int i = it + b * stride;
        if (i < nitems) { const int kc = i / nblk, nbk = i - kc * nblk;
#pragma unroll
            for (int j = 0; j < 2; ++j) { int r = dest_row(mode, col0 + 128 * nbk + lane + 64 * j); if (perm) r = (r & ~31) + invperm32(r & 31);
                float q[16];
#pragma unroll
                for (int e = 0; e < 16; ++e) q[e] = v[b][j][e] * gk[b][e];
                v4u o;
                if (i8) { o.x = pk4_i8(q[0], q[1], q[2], q[3]); o.y = pk4_i8(q[4], q[5], q[6], q[7]); o.z = pk4_i8(q[8], q[9], q[10], q[11]); o.w = pk4_i8(q[12], q[13], q[14], q[15]); }
                else { o.x = pk4_fp8(q[0], q[1], q[2], q[3]); o.y = pk4_fp8(q[4], q[5], q[6], q[7]); o.z = pk4_fp8(q[8], q[9], q[10], q[11]); o.w = pk4_fp8(q[12], q[13], q[14], q[15]); }
                { GAS v4u* dp = (GAS v4u*)(WT + (size_t)(r >> 8) * tb + ((((size_t)(kc >> 3)) * 8 + (kc & 7)) * 256 + (r & 255)) * 16); if constexpr (NTS) __builtin_nontemporal_store(o, dp); else *dp = o; } } } }
}
template <int NBAT>
__device__ __forceinline__ void conv_had_items(const float* W, int N, unsigned char* WT, int K, int it, int stride, int nitems, int lane, float wscale) {
    const int nblk = N >> 6; const size_t tb = (size_t)256 * K;
    float v[NBAT][32];
#pragma unroll
    for (int b = 0; b < NBAT; ++b) { const int i = it + b * stride, ic = i < nitems ? i : nitems - 1, kc = ic / nblk, nbk = ic - kc * nblk;
        const float* src = W + (size_t)(32 * kc) * N + 64 * nbk + lane;
#pragma unroll
        for (int e = 0; e < 32; ++e) v[b][e] = __builtin_nontemporal_load(src + (size_t)e * N); }
#pragma unroll
    for (int b = 0; b < NBAT; ++b) { const int i = it + b * stride;
        if (i < nitems) { const int kc = i / nblk, nbk = i - kc * nblk, r = 64 * nbk + lane;
#pragma unroll
            for (int st = 1; st < 32; st <<= 1)
#pragma unroll
                for (int e = 0; e < 32; ++e) if (!(e & st)) { const float t = v[b][e]; v[b][e] = t + v[b][e + st]; v[b][e + st] = t - v[b][e + st]; }
#pragma unroll
            for (int h = 0; h < 2; ++h) { const int kc16 = 2 * kc + h; v4u o;
                o.x = pk4_i8(v[b][16 * h + 0] * wscale, v[b][16 * h + 1] * wscale, v[b][16 * h + 2] * wscale, v[b][16 * h + 3] * wscale);
                o.y = pk4_i8(v[b][16 * h + 4] * wscale, v[b][16 * h + 5] * wscale, v[b][16 * h + 6] * wscale, v[b][16 * h + 7] * wscale);
                o.z = pk4_i8(v[b][16 * h + 8] * wscale, v[b][16 * h + 9] * wscale, v[b][16 * h + 10] * wscale, v[b][16 * h + 11] * wscale);
                o.w = pk4_i8(v[b][16 * h + 12] * wscale, v[b][16 * h + 13] * wscale, v[b][16 * h + 14] * wscale, v[b][16 * h + 15] * wscale);
                *(GAS v4u*)(WT + (size_t)(r >> 8) * tb + ((((size_t)(kc16 >> 3)) * 8 + (kc16 & 7)) * 256 + (r & 255)) * 16) = o; } } }
}
__device__ __forceinline__ void rms_row_to_bf16(const float* xrow, const float* g, bf16* orow, int lane) {
    const f32x4* xr = (const f32x4*)xrow + lane; const f32x4* gr = (const f32x4*)g + lane;
    f32x4 v[16]; float s = 0.f;
#pragma unroll
    for (int j = 0; j < 16; ++j) { v[j] = xr[64 * j]; s += (v[j].x * v[j].x + v[j].y * v[j].y) + (v[j].z * v[j].z + v[j].w * v[j].w); }
    const float r = 1.f / sqrtf(wave_sum(s) * (1.f / DM) + EPS);
    v2u* o8 = (v2u*)orow + lane;
#pragma unroll
    for (int j = 0; j < 16; ++j) { const f32x4 gg = gr[64 * j]; v2u w; w.x = pk2(v[j].x * r * gg.x, v[j].y * r * gg.y); w.y = pk2(v[j].z * r * gg.z, v[j].w * r * gg.w); o8[64 * j] = w; }
}

template <int TM>
__device__ __forceinline__ void thin_phase(const bf16* FB, const bf16* XB, bf16* XR, float* RSo, float* out, const LAS f32x4* g1, int gw, int NGW, int lane, unsigned char* X8 = nullptr, float* RSq = nullptr) {
    constexpr float SC1 = (TM == 1) ? 1.f : 0.5f;
    const bf16* XS = (TM == 0) ? XB : XR;
    f32x4 va[16], vb[16]; v2u xh[16];
#define TH_LOAD(dst, mm) do { const v2u* fr_ = (const v2u*)(FB + (size_t)(mm) * DM) + lane; \
        _Pragma("unroll") for (int j = 0; j < 16; ++j) { const v2u w_ = fr_[64 * j]; dst[j] = (f32x4){bflo(w_.x), bfhi(w_.x), bflo(w_.y), bfhi(w_.y)}; } \
        { const v2u* xr_ = (const v2u*)(XS + (size_t)(mm) * DM) + lane; _Pragma("unroll") for (int j = 0; j < 16; ++j) xh[j] = xr_[64 * j]; } } while (0)
#define TH_ROW(cur, nxt, mm, mnext) do { float s = 0.f; \
        _Pragma("unroll") for (int j = 0; j < 16; ++j) s += (cur[j].x * cur[j].x + cur[j].y * cur[j].y) + (cur[j].z * cur[j].z + cur[j].w * cur[j].w); \
        const float r1 = SC1 / sqrtf(wave_sum(s) * (1.f / DM) + EPS); float s2 = 0.f, amax = 1e-20f; \
        asm volatile("" ::: "memory"); \
        _Pragma("unroll") for (int j = 0; j < 16; ++j) { const f32x4 xb = (f32x4){bflo(xh[j].x), bfhi(xh[j].x), bflo(xh[j].y), bfhi(xh[j].y)}; \
            cur[j] = xb + cur[j] * r1 * g1[64 * j + lane]; \
            if constexpr (TM == 2) { ((f32x4*)(out + (size_t)(mm) * DM) + lane)[64 * j] = cur[j]; } \
            else { v2u w; w.x = pg8::cvt_pk_bf16(cur[j].x, cur[j].y); w.y = pg8::cvt_pk_bf16(cur[j].z, cur[j].w); ((v2u*)(XR + (size_t)(mm) * DM) + lane)[64 * j] = w; \
                   const f32x4 q = (f32x4){bflo(w.x), bfhi(w.x), bflo(w.y), bfhi(w.y)}; s2 += (q.x * q.x + q.y * q.y) + (q.z * q.z + q.w * q.w); \
                   if constexpr (TM != 2) amax = fmaxf(fmaxf(amax, fmaxf(fabsf(cur[j].x), fabsf(cur[j].y))), fmaxf(fabsf(cur[j].z), fabsf(cur[j].w))); } } \
        asm volatile("" ::: "memory"); \
        if ((mnext) < M) TH_LOAD(nxt, mnext); \
        asm volatile("" ::: "memory"); \
        if constexpr (TM != 2) { const float r2 = 1.f / sqrtf(wave_sum(s2) * (1.f / DM) + EPS); \
            const float am = wave_max(amax), qs = 127.f / am; if (lane == 0) { RSo[mm] = r2; RSq[mm] = am * r2 * (1.f / 127.f); }        \
            _Pragma("unroll") for (int j = 0; j < 16; ++j) ((unsigned*)(X8 + (size_t)(mm) * DM) + lane)[64 * j] = pk4_i8(cur[j].x * qs, cur[j].y * qs, cur[j].z * qs, cur[j].w * qs); } \
        asm volatile("" ::: "memory"); } while (0)
    int m = gw;
    if (m < M) TH_LOAD(va, m);
    while (m < M) {
        int mn = m + NGW;
        TH_ROW(va, vb, m, mn);
        m = mn; if (m >= M) break; mn = m + NGW;
        TH_ROW(vb, va, m, mn);
        m = mn;
    }
#undef TH_LOAD
#undef TH_ROW
}

__global__ void __launch_bounds__(NTHR, 2) fwd(Args args) {
    extern __shared__ __attribute__((aligned(16))) unsigned char lds_raw[];
    LAS unsigned char* lds = (LAS unsigned char*)lds_raw;
    const int G = gridDim.x, bx = blockIdx.x;
    const int WV = __builtin_amdgcn_readfirstlane((int)threadIdx.x >> 6);
    const int vcu = (G % 8 == 0) ? (bx % 8) * (G / 8) + bx / 8 : bx;
    const int NGW = G * NWAVES;
#define PHASE_IDS() int tid = tid_of(WV); asm volatile("" : "+v"(tid)); const int lane = tid & 63, wave = __builtin_amdgcn_readfirstlane(tid >> 6), gw = vcu * NWAVES + wave; (void)lane; (void)gw
    unsigned char* ws = args.ws;
    unsigned* ctl = (unsigned*)(ws + WS_CTL);
    const int lo = args.ph_lo, hi = args.ph_hi;
    if (threadIdx.x < 4) ((LAS unsigned*)(lds + MISC_OFF))[threadIdx.x] = 0u;
    __syncthreads();
    XcdBarrier bar; bar.bar = ctl + CW_BAR; bar.x = 0; bar.st = nullptr; bar.wv = WV;
    if (hi - lo > 1) bar = xcd_barrier_post(ctl + CW_BAR, (volatile LAS unsigned*)(lds + MISC_OFF), WV);
#define IN(k) (lo <= (k) && (k) < hi)
#define SEAM(k) do { if (IN(k) && IN((k) + 1)) xcd_barrier(bar); } while (0)

    const float* x = args.in[I_X];
    bf16* WGU1 = (bf16*)(ws + WS_WGU1); bf16* WD1 = (bf16*)(ws + WS_WD1); bf16* WIN = (bf16*)(ws + WS_WIN);
    bf16* WAO = (bf16*)(ws + WS_WAO); bf16* WRO = (bf16*)(ws + WS_WRO); bf16* WOt = (bf16*)(ws + WS_WO);
    bf16* WGU2 = (bf16*)(ws + WS_WGU2); bf16* WD2 = (bf16*)(ws + WS_WD2);
    bf16* ACT = (bf16*)(ws + WS_ACT); bf16* HB = (bf16*)(ws + WS_H); bf16* FB = (bf16*)(ws + WS_F); bf16* XR = (bf16*)(ws + WS_XR);
    bf16* QB = (bf16*)(ws + WS_H); bf16* KB = QB + (size_t)M * AW; bf16* VB = KB + (size_t)M * AW; bf16* XREC = VB + (size_t)M * AW; bf16* XGATE = XREC + (size_t)M * AW;
    bf16* SAb = (bf16*)(ws + WS_F); bf16* SBb = SAb + (size_t)M * DM;
    bf16* ATT = ACT; bf16* YREC = ACT + (size_t)M * AW;
    bf16* MG = (bf16*)(ws + WS_MG);
    float* RS = (float*)(ws + WS_RS);
    float* CS = (float*)(ws + WS_ROPE); float* SN = CS + SEQ * 64; float* KM = (float*)(ws + WS_KM); float* SPt = (float*)(ws + WS_SP);

    if (IN(0)) {
        PHASE_IDS();
        constexpr int I_GU = (DM / 8) * (FF / 256), I_IN = (DM / 8) * (INC / 256), I_AO = (AW / 8) * (DM / 256), I_OO = (DM / 8) * (DM / 256);
#define CONV_ALL(Wsrc, Ncols, Wdst, mode_, perm_, K_, nit, gain_) for (int it = gw; it < (nit); it += 2 * NGW) conv_stream_items<2>(Wsrc, Ncols, Wdst, mode_, perm_, K_, it, NGW, nit, lane, gain_)
        { constexpr int C8 = 128 * F1T, NCB = (FF - C8) / 256, I_B = (DM / 8) * NCB, I_8 = (DM / 16) * F1T;
          for (int it = gw; it < I_8; it += 2 * NGW) conv_stream_items8<2>(args.in[I_F1G], FF, (unsigned char*)WGU1, DM, it, NGW, I_8, lane, WGI_SCALE, 1, true, args.in[I_F1PRE], F1T, (size_t)512 * DM, true);
          for (int it = gw; it < I_8; it += 2 * NGW) conv_stream_items8<2>(args.in[I_F1U], FF, (unsigned char*)WGU1, DM, it, NGW, I_8, lane, WGI_SCALE, 2, true, args.in[I_F1PRE], F1T, (size_t)512 * DM, true);
          if (NCB > 0) { for (int it = gw; it < I_B; it += 2 * NGW) conv_stream_items<2>(args.in[I_F1G], FF, WGU1, 1, true, DM, it, NGW, I_B, lane, args.in[I_F1PRE], C8, NCB);
                         for (int it = gw; it < I_B; it += 2 * NGW) conv_stream_items<2>(args.in[I_F1U], FF, WGU1, 2, true, DM, it, NGW, I_B, lane, args.in[I_F1PRE], C8, NCB); } }
#undef CONV_ALL
        for (int m = gw; m < M; m += NGW) {
            const f32x4* xr = (const f32x4*)(x + (size_t)m * DM) + lane; f32x4 v[16]; float ss = 0.f;
            float amax = 1e-20f;
#pragma unroll
            for (int j = 0; j < 16; ++j) { v[j] = xr[64 * j]; ss += (v[j].x * v[j].x + v[j].y * v[j].y) + (v[j].z * v[j].z + v[j].w * v[j].w);
                amax = fmaxf(fmaxf(amax, fmaxf(fabsf(v[j].x), fabsf(v[j].y))), fmaxf(fabsf(v[j].z), fabsf(v[j].w))); }
            const float r = 1.f / sqrtf(wave_sum(ss) * (1.f / DM) + EPS), am = wave_max(amax), qs = 127.f / am; if (lane == 0) { RS[m] = r; RS[5 * M + m] = am * r * (1.f / 127.f); }
#pragma unroll
            for (int j = 0; j < 16; ++j) ((unsigned*)((unsigned char*)MG + (size_t)m * DM) + lane)[64 * j] = pk4_i8(v[j].x * qs, v[j].y * qs, v[j].z * qs, v[j].w * qs);
            v2u* o8 = (v2u*)(ACT + (size_t)m * DM) + lane;
#pragma unroll
            for (int j = 0; j < 16; ++j) { v2u w; w.x = pg8::cvt_pk_bf16(v[j].x, v[j].y); w.y = pg8::cvt_pk_bf16(v[j].z, v[j].w); o8[64 * j] = w; }
        }
        const int gt = vcu * NTHR + tid, NGT = G * NTHR;
        for (int i = gt; i < SEQ * 64; i += NGT) { const int s = i >> 6, f = i & 63;
            const float inv = powf(10000.0f, -(float)(2 * f) / 128.0f); const float ang = (float)s * inv;
            const double a = (double)ang; const double k = rint(a * 0.15915494309189535); const float rr = (float)(a - k * 6.283185307179586);
            CS[i] = cosf(rr); SN[i] = sinf(rr); }
        for (int i = gt; i < LW; i += NGT) { const float xl = -args.in[I_LAM][i]; SPt[i] = fmaxf(xl, 0.f) + log1pf(expf(-fabsf(xl))); }
    }
    SEAM(0);
    if (IN(1)) {
        { const int xs = bx & 7;
          pg8::Gemm g = pg8::gemm_chunkB8(MG, WGU1, DM, DM, (size_t)512 * DM);
          EpiSwiGLU<2, true, true> E{HB, RS + 5 * M, 1.f / WGI_SCALE};
          { pg8::StaticOrder S; S.init(M, 256 * F1T, G, bx); S.iend = xs + 1;
            pg8::gemm_phase<EpiSwiGLU<2, true, true>, pg8::StaticOrder, 0, false, false, true>(lds + RING_OFF, g, S, E, WV); }
        { PHASE_IDS();
          constexpr int I_OO = (DM / 8) * (DM / 256);
#define CONV_ALL(Wsrc, Ncols, Wdst, mode_, perm_, K_, nit, gain_) for (int it = gw; it < (nit); it += 2 * NGW) conv_stream_items<2, true>(Wsrc, Ncols, Wdst, mode_, perm_, K_, it, NGW, nit, lane, gain_)
        {
            constexpr int IB1 = (DM / 8) * I8A0, IB2 = (DM / 8) * (I8B0 - I8A1), I81 = (DM / 16) * 2 * (I8A1 - I8A0), I82 = (DM / 16) * 2 * (INC / 256 - I8B0);
            for (int it = gw; it < IB1; it += 2 * NGW) conv_stream_items<2, true>(args.in[I_WIN], INC, WIN, 3, true, DM, it, NGW, IB1, lane, args.in[I_MIXPRE], 0, I8A0);
            if (IB2 > 0) for (int it = gw; it < IB2; it += 2 * NGW) conv_stream_items<2, true>(args.in[I_WIN], INC, WIN, 3, true, DM, it, NGW, IB2, lane, args.in[I_MIXPRE], 256 * I8A1, I8B0 - I8A1);
            if (I81 > 0) for (int it = gw; it < I81; it += 2 * NGW) conv_stream_items8<2, true>(args.in[I_WIN], INC, (unsigned char*)WIN, DM, it, NGW, I81, lane, WGI_SCALE, 3, true, args.in[I_MIXPRE], 2 * (I8A1 - I8A0), (size_t)512 * DM, true, 256 * I8A0);
            for (int it = gw; it < I82; it += 2 * NGW) conv_stream_items8<2, true>(args.in[I_WIN], INC, (unsigned char*)WIN, DM, it, NGW, I82, lane, WGI_SCALE, 3, true, args.in[I_MIXPRE], 2 * (INC / 256 - I8B0), (size_t)512 * DM, true, 256 * I8B0); }
        CONV_ALL(args.in[I_WO], DM, WOt, 0, false, DM, I_OO, nullptr);
        { constexpr int I_8 = (DM / 16) * (FF / 128);
          for (int it = gw; it < I_8; it += 2 * NGW) conv_stream_items8<2, true>(args.in[I_F2G], FF, (unsigned char*)WGU2, DM, it, NGW, I_8, lane, WGI_SCALE, 1, true, args.in[I_F2PRE], FF / 128, (size_t)256 * DM, true);
          for (int it = gw; it < I_8; it += 2 * NGW) conv_stream_items8<2, true>(args.in[I_F2U], FF, (unsigned char*)WGU2, DM, it, NGW, I_8, lane, WGI_SCALE, 2, true, args.in[I_F2PRE], FF / 128, (size_t)256 * DM, true); }
#undef CONV_ALL
        }
          { pg8::StaticOrder S; S.init(M, 256 * F1T, G, bx); S.ibeg = xs + 1;
            pg8::gemm_phase<EpiSwiGLU<2, true, true>, pg8::StaticOrder, 0, false, false, true>(lds + RING_OFF, g, S, E, WV); } }
        if (F1T < 2 * FF / 256) {
        pg8::Gemm g = pg8::gemm_chunkB(ACT, ACT, WGU1, WGU1, DM, DM, 2 * FF); pg8::StaticOrder S; S.init(M, 2 * FF - 256 * F1T, G, bx, F1T);
        EpiSwiGLU<2> E{HB, RS, 1.f};
        pg8::gemm_phase<EpiSwiGLU<2>, pg8::StaticOrder, 0, false>(lds + RING_OFF, g, S, E, WV); }
        { const int nun = (M / 256) * ((F1T < 2 * FF / 256) ? 2 * FF / 256 - F1T : 2 * FF / 256), full = nun % G; constexpr int NI = (FF / 32) * (DM / 64);
          PHASE_IDS();
          if (full != 0) { if (bx >= full) { const int nw = (G - full) * NWAVES;
              for (int it = (bx - full) * NWAVES + wave; it < NI; it += 2 * nw) conv_had_items<2>(args.in[I_F1D], DM, (unsigned char*)WD1, FF, it, nw, NI, lane, WQ_SCALE); } }
          else { for (int it = gw; it < NI; it += 2 * NGW) conv_had_items<2>(args.in[I_F1D], DM, (unsigned char*)WD1, FF, it, NGW, NI, lane, WQ_SCALE); } }
    }
    SEAM(1);
    if (IN(2)) {
        pg8::Gemm g = pg8::gemm_chunkB8(HB, WD1, FF, FF); pg8::StaticOrder S; S.init(M, DM, G, bx);
        EpiF32I E{FB, DM, DQ_SCALE};
        pg8::gemm_phase<EpiF32I, pg8::StaticOrder, 0, false, false, true>(lds + RING_OFF, g, S, E, WV);
    }
    SEAM(2);
    if (IN(3)) {
        PHASE_IDS();
        LAS f32x4* g1 = (LAS f32x4*)(lds + RING_OFF);
        for (int i = tid; i < DM / 4; i += NTHR) g1[i] = ((const f32x4*)args.in[I_F1POST])[i];
        __syncthreads();
        thin_phase<0>(FB, ACT, XR, RS + M, nullptr, g1, gw, NGW, lane, (unsigned char*)MG, RS + 3 * M);
        __syncthreads();
    }
    SEAM(3);
    if (IN(4)) {
        { pg8::Gemm g = pg8::gemm_chunkB(XR, XR, WIN, WIN, DM, DM, INC); EpiProj E{QB, SAb, CS, SN, KM, RS + M};
          pg8::StaticOrder S; S.init(M, 256 * (I8A0 + I8B0 - I8A1), G, bx, 0, I8A0, I8A1 - I8A0); pg8::gemm_phase<EpiProj, pg8::StaticOrder, 0, false>(lds + RING_OFF, g, S, E, WV); }
        { pg8::Gemm g = pg8::gemm_chunkB8(MG, WIN, DM, DM, (size_t)512 * DM); EpiProjI E{EpiProj{QB, SAb, CS, SN, KM, RS + M}, RS + 3 * M, 1.f / WGI_SCALE};
          pg8::StaticOrder S; S.init(M, 256 * (I8A1 - I8A0) + INC - 256 * I8B0, G, bx, I8A0, I8A1 - I8A0, I8B0 - I8A1); pg8::gemm_phase<EpiProjI, pg8::StaticOrder, 0, false, false, true>(lds + RING_OFF, g, S, E, WV); }
    }
    SEAM(4);
    if (IN(7)) {
        PHASE_IDS();
        {
            typedef att::bf16x8 bf8; typedef att::f32x16 f16v;
            LAS float* cwl = (LAS float*)(lds + RING_OFF);
            LAS float* summ = (LAS float*)(lds + RING_OFF + 4096);
            const float* cw = args.in[I_CONVW]; const float* cb = args.in[I_CONVB];
            static_assert(NB * 64 * 8 * 8 * 2 == 2 * (AW / 8) * (DM / 64), "hosted conversion groups");
            for (int unit = vcu; unit < NB * 64; unit += G) {
                const int b = unit >> 6, n = (unit >> 2) & 15, q = unit & 3, C0 = 128 * n + 32 * q;
                int tl = tid_of(WV); asm volatile("" : "+v"(tl));
                const int lane2 = tl & 63, d = lane2 & 31, hi = lane2 >> 5, wave2 = __builtin_amdgcn_readfirstlane(tl >> 6);
                LAS unsigned char* xs = lds + RING_OFF + 8192 + wave2 * 12288;
                LAS unsigned char* gs = xs + 9728; LAS unsigned char* ys = xs;
                __syncthreads();
                for (int i = tl; i < 5 * 128; i += NTHR) { const int tap = i >> 7, c = i & 127; cwl[i] = tap < 4 ? cw[tap * LW + 128 * n + c] : cb[128 * n + c]; }
                LAS v4u* wfr = (LAS v4u*)(lds + RING_OFF + 8192 + 8 * 12288);
                { const int ks = wave2; float wa[8], wx[8];
#pragma unroll
                    for (int e = 0; e < 8; ++e) { const size_t o = ((size_t)n * 128 + 16 * ks + 8 * hi + e) * 128 + 32 * q + d; wa[e] = args.in[I_RGWA][o]; wx[e] = args.in[I_RGWX][o]; }
                    v4u pa, px; pa.x = pg8::cvt_pk_bf16(wa[0], wa[1]); pa.y = pg8::cvt_pk_bf16(wa[2], wa[3]); pa.z = pg8::cvt_pk_bf16(wa[4], wa[5]); pa.w = pg8::cvt_pk_bf16(wa[6], wa[7]);
                    px.x = pg8::cvt_pk_bf16(wx[0], wx[1]); px.y = pg8::cvt_pk_bf16(wx[2], wx[3]); px.z = pg8::cvt_pk_bf16(wx[4], wx[5]); px.w = pg8::cvt_pk_bf16(wx[6], wx[7]);
                    wfr[(ks * 64 + lane2) * 2] = pa; wfr[(ks * 64 + lane2) * 2 + 1] = px; }
                const float bav = args.in[I_RGBA][C0 + d], bxv = args.in[I_RGBX][C0 + d], spv = SPt[C0 + d];
                float Sround = 0.f;
                v4u xq[9], gq[2];
#define LRU_LOAD(rho_) do { const int t0_ = 256 * (rho_) + 32 * wave2; \
                    _Pragma("unroll") for (int i_ = 0; i_ < 9; ++i_) { const int pc = lane2 + 64 * i_, rr = pc >> 4, c16 = pc & 15, ts = t0_ - 3 + rr; xq[i_] = (v4u){0u, 0u, 0u, 0u}; \
                        if (pc < 560 && ts >= 0) xq[i_] = *(const v4u*)(XREC + ((size_t)b * SEQ + ts) * LW + 128 * n + 8 * c16); } \
                    _Pragma("unroll") for (int i_ = 0; i_ < 2; ++i_) { const int pc = lane2 + 64 * i_, rr = pc >> 2, c16 = pc & 3; gq[i_] = *(const v4u*)(XGATE + ((size_t)b * SEQ + t0_ + rr) * LW + C0 + 8 * c16); } } while (0)
                LRU_LOAD(0);
                __syncthreads();
#pragma unroll 1
                for (int rho = 0; rho < 8; ++rho) {
                    const int t0 = 256 * rho + 32 * wave2;
#pragma unroll
                    for (int i_ = 0; i_ < 9; ++i_) { const int pc = lane2 + 64 * i_; if (pc < 560) *(LAS v4u*)(xs + (pc >> 4) * 272 + (pc & 15) * 16) = xq[i_]; }
#pragma unroll
                    for (int i_ = 0; i_ < 2; ++i_) { const int pc = lane2 + 64 * i_; *(LAS v4u*)(gs + (pc >> 2) * 80 + (pc & 3) * 16) = gq[i_]; }
                    if (rho < 7) LRU_LOAD(rho + 1);
                    float cvl[2][8]; const int cg0 = ((unit * 8 + rho) * 8 + wave2) * 2;
#pragma unroll
                    for (int gi = 0; gi < 2; ++gi) { const int gid = cg0 + gi, jm = gid >> 14, gl = gid & 16383, kc = gl >> 6, nbq = gl & 63;
                        const float* wsrc = (jm == 0 ? args.in[I_WAO] : args.in[I_WRO]) + (size_t)(8 * kc) * DM + 64 * nbq + lane2;
#pragma unroll
                        for (int e = 0; e < 8; ++e) cvl[gi][e] = wsrc[(size_t)e * DM]; }
                    LDS_WAIT();
                    f16v accA = {}, accX = {}, accI = {};
#pragma unroll
                    for (int ks = 0; ks < 8; ++ks) {
                        const int cc = 16 * ks + 8 * hi;
                        f2v xc[4];
                        { const f32x4 b0 = *(const LAS f32x4*)(cwl + 512 + cc), b1 = *(const LAS f32x4*)(cwl + 512 + cc + 4);
                          xc[0] = (f2v){b0.x, b0.y}; xc[1] = (f2v){b0.z, b0.w}; xc[2] = (f2v){b1.x, b1.y}; xc[3] = (f2v){b1.z, b1.w}; }
#pragma unroll
                        for (int tap = 0; tap < 4; ++tap) {
                            const v4u xw = *(const LAS v4u*)(xs + (d + tap) * 272 + cc * 2);
                            const f32x4 w0 = *(const LAS f32x4*)(cwl + tap * 128 + cc), w1 = *(const LAS f32x4*)(cwl + tap * 128 + cc + 4);
                            xc[0] += (f2v){w0.x, w0.y} * (f2v){bflo(xw.x), bfhi(xw.x)}; xc[1] += (f2v){w0.z, w0.w} * (f2v){bflo(xw.y), bfhi(xw.y)};
                            xc[2] += (f2v){w1.x, w1.y} * (f2v){bflo(xw.z), bfhi(xw.z)}; xc[3] += (f2v){w1.z, w1.w} * (f2v){bflo(xw.w), bfhi(xw.w)}; }
                        v4u af; af.x = pg8::cvt_pk_bf16(xc[0].x, xc[0].y); af.y = pg8::cvt_pk_bf16(xc[1].x, xc[1].y); af.z = pg8::cvt_pk_bf16(xc[2].x, xc[2].y); af.w = pg8::cvt_pk_bf16(xc[3].x, xc[3].y);
                        const bf8 Af = __builtin_bit_cast(bf8, af);
                        const int e1 = 32 * q + d - cc;
                        v4u idw; idw.x = (e1 == 0) ? 0x00003F80u : (e1 == 1 ? 0x3F800000u : 0u); idw.y = (e1 == 2) ? 0x00003F80u : (e1 == 3 ? 0x3F800000u : 0u);
                        idw.z = (e1 == 4) ? 0x00003F80u : (e1 == 5 ? 0x3F800000u : 0u); idw.w = (e1 == 6) ? 0x00003F80u : (e1 == 7 ? 0x3F800000u : 0u);
                        const bf8 Bak = __builtin_bit_cast(bf8, wfr[(ks * 64 + lane2) * 2]), Bxk = __builtin_bit_cast(bf8, wfr[(ks * 64 + lane2) * 2 + 1]);
                        accA = __builtin_amdgcn_mfma_f32_32x32x16_bf16(Af, Bak, accA, 0, 0, 0);
                        accX = __builtin_amdgcn_mfma_f32_32x32x16_bf16(Af, Bxk, accX, 0, 0, 0);
                        accI = __builtin_amdgcn_mfma_f32_32x32x16_bf16(Af, __builtin_bit_cast(bf8, idw), accI, 0, 0, 0);
                    }
                    float Pp[16], Hl[16], gA[4], gH[4];
#pragma unroll
                    for (int jp = 0; jp < 2; ++jp) {
                        constexpr float L2E = 1.4426950408889634f; const float c8 = -8.f * spv * L2E, c16 = -16.f * spv;
                        f2v pp = {1.f, 1.f}, hh = {0.f, 0.f};
#pragma unroll
                        for (int k = 0; k < 4; ++k) { const int r0 = 8 * jp + k, r1 = r0 + 4;
                            const f2v ea = ((f2v){accA[r0], accA[r1]} + bav) * -L2E, ex = ((f2v){accX[r0], accX[r1]} + bxv) * -L2E;
                            const f2v da = (f2v){__builtin_amdgcn_exp2f(ea.x), __builtin_amdgcn_exp2f(ea.y)} + 1.f, dx = (f2v){__builtin_amdgcn_exp2f(ex.x), __builtin_amdgcn_exp2f(ex.y)} + 1.f;
                            const f2v rg = {__builtin_amdgcn_rcpf(da.x), __builtin_amdgcn_rcpf(da.y)}, ig = {__builtin_amdgcn_rcpf(dx.x), __builtin_amdgcn_rcpf(dx.y)};
                            const f2v l2 = rg * c8, x = rg * c16;
                            const f2v av = {__builtin_amdgcn_exp2f(l2.x), __builtin_amdgcn_exp2f(l2.y)};
                            f2v p = x * 0.0013888889f + 0.0083333338f; p = p * x + 0.041666668f; p = p * x + 0.16666667f; p = p * x + 0.5f; p = p * x + 1.f; p = -x * p;
                            const f2v alt = 1.f - av * av;
                            const f2v ome = {x.x > -0.3f ? p.x : alt.x, x.y > -0.3f ? p.y : alt.y};
                            const f2v uv = (f2v){accI[r0], accI[r1]} * ig * (f2v){__builtin_amdgcn_sqrtf(ome.x), __builtin_amdgcn_sqrtf(ome.y)};
                            hh = av * hh + uv; pp = pp * av; Pp[r0] = pp.x; Pp[r1] = pp.y; Hl[r0] = hh.x; Hl[r1] = hh.y; }
                        gA[2 * jp] = pp.x; gA[2 * jp + 1] = pp.y; gH[2 * jp] = hh.x; gH[2 * jp + 1] = hh.y; }
                    float cin[4], pin[4]; float sl = 0.f, pl = 1.f;
#pragma unroll
                    for (int j = 0; j < 4; ++j) { const float oA = __shfl_xor(gA[j], 32), oH = __shfl_xor(gH[j], 32);
                        const float fA = hi ? oA : gA[j], fH = hi ? oH : gH[j], sA = hi ? gA[j] : oA, sH = hi ? gH[j] : oH;
                        const float c1 = sl, p1 = pl; sl = fA * sl + fH; pl *= fA; const float c2 = sl, p2 = pl; sl = sA * sl + sH; pl *= sA;
                        cin[j] = hi ? c2 : c1; pin[j] = hi ? p2 : p1; }
                    LAS float* sm = summ + (rho & 1) * 512;
                    if (hi == 0) { sm[wave2 * 64 + d] = pl; sm[wave2 * 64 + 32 + d] = sl; }
                    __syncthreads();
                    float s = Sround, myin = 0.f;
#pragma unroll
                    for (int w2 = 0; w2 < 8; ++w2) { const float A2 = sm[w2 * 64 + d], H2 = sm[w2 * 64 + 32 + d]; if (w2 == wave2) myin = s; s = A2 * s + H2; }
                    Sround = s;
#pragma unroll
                    for (int j = 0; j < 4; ++j) { const float ci = cin[j] + pin[j] * myin;
#pragma unroll
                        for (int k = 0; k < 4; ++k) { const int r = 4 * j + k, tr = k + 8 * j + 4 * hi;
                            const float h = Hl[r] + Pp[r] * ci;
                            const float gte = __builtin_bit_cast(float, (unsigned)*(const LAS unsigned short*)(gs + tr * 80 + d * 2) << 16);
                            *(LAS unsigned short*)(ys + tr * 80 + d * 2) = (unsigned short)f2bf(h * gte); } }
                    LDS_WAIT();
#pragma unroll
                    for (int i_ = 0; i_ < 2; ++i_) { const int pc = lane2 + 64 * i_, rr = pc >> 2, c16 = pc & 3;
                        *(v4u*)(YREC + ((size_t)b * SEQ + t0 + rr) * LW + C0 + 8 * c16) = *(const LAS v4u*)(ys + rr * 80 + c16 * 16); }
#pragma unroll
                    for (int gi = 0; gi < 2; ++gi) { const int gid = cg0 + gi, jm = gid >> 14, gl = gid & 16383, kc = gl >> 6, nbq = gl & 63;
                        int r = 64 * nbq + lane2; r = (r & ~31) + invperm32(r & 31);
                        bf16* wdst = jm == 0 ? WAO : WRO; const int Kj = AW;
                        v4u o; o.x = pg8::cvt_pk_bf16(cvl[gi][0], cvl[gi][1]); o.y = pg8::cvt_pk_bf16(cvl[gi][2], cvl[gi][3]); o.z = pg8::cvt_pk_bf16(cvl[gi][4], cvl[gi][5]); o.w = pg8::cvt_pk_bf16(cvl[gi][6], cvl[gi][7]);
                        *(GAS v4u*)(wdst + ((((size_t)(r >> 8) * (Kj >> 6) + (kc >> 3)) * 8 + (kc & 7)) * 256 + (r & 255)) * 8) = o; }
                }
#undef LRU_LOAD
            }
            __syncthreads();
        }
        {
            typedef unsigned short abf;
            char* alds = (char*)lds_raw;
            LAS float* kml = (LAS float*)(lds + 69632);
            LAS unsigned char* rmask = (LAS unsigned char*)(lds + 73728);
            for (int pr_ = vcu; pr_ < NB * NH * 4; pr_ += G) {
                const int bh = pr_ >> 2, j0 = pr_ & 3, b = bh / NH, h = bh % NH;
                int tg = tid_of(WV); asm volatile("" : "+v"(tg));
                {
                    const int jmax = 7 - j0;
                    __syncthreads();
                    for (int idx = tg; idx < jmax * 128; idx += NTHR) { const int n = idx >> 7, d = idx & 127; const size_t ko = ((size_t)(b * 8 + n)) * AW + h * HD + d;
                        kml[idx] = (KM[ko] + KM[(size_t)32 * AW + ko]) * (1.f / 256.f); }
                    __syncthreads();
                    const int pass = __builtin_amdgcn_readfirstlane(tg >> 8), row = tg & 255, jb = pass ? 7 - j0 : j0;
                    {
                        const v4u* qp = (const v4u*)(QB + ((size_t)b * SEQ + jb * 256 + row) * AW + h * HD);
                        float gsc[7];
#pragma unroll
                        for (int n = 0; n < 7; ++n) gsc[n] = 0.f;
#pragma unroll 2
                        for (int c = 0; c < 16; ++c) { const v4u qw = qp[c];
                            const float qv[8] = {bflo(qw.x), bfhi(qw.x), bflo(qw.y), bfhi(qw.y), bflo(qw.z), bfhi(qw.z), bflo(qw.w), bfhi(qw.w)};
#pragma unroll
                            for (int n = 0; n < 7; ++n) if (n < jb) { const f32x4 ka = *(const LAS f32x4*)(kml + n * 128 + 8 * c), kb = *(const LAS f32x4*)(kml + n * 128 + 8 * c + 4);
                                gsc[n] += qv[0] * ka.x + qv[1] * ka.y + qv[2] * ka.z + qv[3] * ka.w + qv[4] * kb.x + qv[5] * kb.y + qv[6] * kb.z + qv[7] * kb.w; } }
                        unsigned sel = 0u;
#pragma unroll
                        for (int k = 0; k < MOBA_TOPK; ++k) { int best = -1; float bv = -__builtin_inff();
#pragma unroll
                            for (int n = 0; n < 7; ++n) if (n < jb && !((sel >> n) & 1u) && gsc[n] > bv) { bv = gsc[n]; best = n; }
                            if (best >= 0) sel |= 1u << best; }
                        rmask[pass * 256 + row] = (unsigned char)sel;
                    }
                }
                __syncthreads();
                const abf* Qh = QB + (size_t)b * SEQ * AW + h * HD; const abf* Kh = KB + (size_t)b * SEQ * AW + h * HD; const abf* Vh = VB + (size_t)b * SEQ * AW + h * HD; abf* Oh = ATT + (size_t)b * SEQ * AW + h * HD;
                att::BlockRef<abf, abf> c0, c1;
                c0.Q = Qh + (size_t)(j0 * 256) * AW; c0.K = Kh; c0.V = Vh; c0.O = Oh + (size_t)(j0 * 256) * AW; c0.P0 = j0 * 256;
                c1.Q = Qh + (size_t)((7 - j0) * 256) * AW; c1.K = Kh; c1.V = Vh; c1.O = Oh + (size_t)((7 - j0) * 256) * AW; c1.P0 = (7 - j0) * 256;
                att::Seam<abf> Sm;
                att::causal_swa_prime<abf, abf>(c0, 1 << 30, alds, Sm, WV);
                att::causal_swa_block<abf, abf>(c0, c1, SEQ, 1 << 30, alds, Sm, (const LAS unsigned char*)(lds + 73728), WV);
                att::causal_swa_block<abf, abf>(c1, c1, SEQ, 1 << 30, alds, Sm, (const LAS unsigned char*)(lds + 73728 + 256), WV);
                __syncthreads();
            }
        }
    }
    SEAM(7);
    if (IN(8)) {
        pg8::Gemm g = pg8::gemm_chunkB(ATT, YREC, WAO, WRO, AW, AW, DM); pg8::StaticOrder2 S; S.init(M, DM, G, bx);
        EpiMerge E{SAb, SBb, MG};
        pg8::gemm_phase<EpiMerge, pg8::StaticOrder2, 1, false>(lds + RING_OFF, g, S, E, WV);
    }
    SEAM(8);
    if (IN(9)) {
        pg8::Gemm g = pg8::gemm_chunkB(MG, MG, WOt, WOt, DM, DM, DM); pg8::StaticOrder S; S.init(M, DM, G, bx);
        EpiF32 E{FB, DM, 1.f};
        pg8::gemm_phase<EpiF32, pg8::StaticOrder, 0, false>(lds + RING_OFF, g, S, E, WV);
    }
    SEAM(9);
    if (IN(10)) {
        PHASE_IDS();
        LAS f32x4* g1 = (LAS f32x4*)(lds + RING_OFF);
        for (int i = tid; i < DM / 4; i += NTHR) g1[i] = ((const f32x4*)args.in[I_MIXPOST])[i];
        __syncthreads();
        thin_phase<1>(FB, nullptr, XR, RS + 2 * M, nullptr, g1, gw, NGW, lane, (unsigned char*)ACT, RS + 4 * M);
        __syncthreads();
    }
    SEAM(10);
    if (IN(11)) {
        pg8::Gemm g = pg8::gemm_chunkB8(ACT, WGU2, DM, DM, (size_t)256 * DM); pg8::StaticOrder S; S.init(M, 2 * FF, G, bx);
        EpiSwiGLU<2, true, true> E{HB, RS + 4 * M, 1.f / WGI_SCALE};
        pg8::gemm_phase<EpiSwiGLU<2, true, true>, pg8::StaticOrder, 0, false, false, true>(lds + RING_OFF, g, S, E, WV);
        { const int nun = (M / 256) * (2 * FF / 256), full = nun % G; constexpr int NI = (FF / 32) * (DM / 64);
          PHASE_IDS();
          if (full != 0) { if (bx >= full) { const int nw = (G - full) * NWAVES;
              for (int it = (bx - full) * NWAVES + wave; it < NI; it += 2 * nw) conv_had_items<2>(args.in[I_F2D], DM, (unsigned char*)WD2, FF, it, nw, NI, lane, WQ_SCALE); } }
          else { for (int it = gw; it < NI; it += 2 * NGW) conv_had_items<2>(args.in[I_F2D], DM, (unsigned char*)WD2, FF, it, NGW, NI, lane, WQ_SCALE); } }
    }
    SEAM(11);
    if (IN(12)) {
        pg8::Gemm g = pg8::gemm_chunkB8(HB, WD2, FF, FF); pg8::StaticOrder S; S.init(M, DM, G, bx);
        EpiF32I E{FB, DM, DQ_SCALE};
        pg8::gemm_phase<EpiF32I, pg8::StaticOrder, 0, false, false, true>(lds + RING_OFF, g, S, E, WV);
    }
    SEAM(12);
    if (IN(13)) {
        PHASE_IDS();
        LAS f32x4* g1 = (LAS f32x4*)(lds + RING_OFF);
        for (int i = tid; i < DM / 4; i += NTHR) g1[i] = ((const f32x4*)args.in[I_F2POST])[i];
        __syncthreads();
        thin_phase<2>(FB, nullptr, XR, nullptr, args.out, g1, gw, NGW, lane);
    }
#undef IN
#undef SEAM
}
constexpr int NPHASE = 14;

extern "C" void kernel_launch(void* const* d_in, const int* in_sizes, int n_in, void* d_out, int out_size, void* d_ws, size_t ws_size, hipStream_t stream) {
    static int grid = 0;
    if (grid == 0) {
        if (n_in != 24 || in_sizes[0] != M * DM || out_size != M * DM || ws_size < WS_END) { fprintf(stderr, "kernel_launch: unexpected shapes (n_in %d, in0 %d, out %d, ws %zu); nothing launched\n", n_in, n_in > 0 ? in_sizes[0] : -1, out_size, ws_size); grid = -1; return; }
        int dev = 0, cus = 0, per_cu = 0;
        if (hipGetDevice(&dev) != hipSuccess || hipDeviceGetAttribute(&cus, hipDeviceAttributeMultiprocessorCount, dev) != hipSuccess) { grid = -1; return; }
        if (hipFuncSetAttribute((const void*)fwd, hipFuncAttributeMaxDynamicSharedMemorySize, LDS_BYTES) != hipSuccess) { fprintf(stderr, "kernel_launch: hipFuncSetAttribute failed\n"); grid = -1; return; }
        if (hipOccupancyMaxActiveBlocksPerMultiprocessor(&per_cu, (const void*)fwd, NTHR, LDS_BYTES) != hipSuccess || per_cu < 1) fprintf(stderr, "kernel_launch: occupancy query reports %d\n", per_cu);
        (void)hipGetLastError();
        grid = cus;
    }
    if (grid < 0) return;
    if (hipMemsetAsync((char*)d_ws + WS_CTL, 0, CTL_ZERO_BYTES, stream) != hipSuccess) return;
    Args a{};
    for (int i = 0; i < 24; ++i) a.in[i] = (const float*)d_in[i];
    a.out = (float*)d_out; a.ws = (unsigned char*)d_ws;
#if MK_PER_PHASE
    for (int p = 0; p < NPHASE; ++p) { a.ph_lo = p; a.ph_hi = p + 1; hipLaunchKernelGGL(fwd, dim3(grid), dim3(NTHR), LDS_BYTES, stream, a); }
#else
    a.ph_lo = 0; a.ph_hi = NPHASE; hipLaunchKernelGGL(fwd, dim3(grid), dim3(NTHR), LDS_BYTES, stream, a);
#endif
    const hipError_t le = hipPeekAtLastError();
    if (le != hipSuccess) fprintf(stderr, "kernel_launch: launch failed: %s\n", hipGetErrorName(le));
}
```

```cpp
#include <hip/hip_runtime.h>
#include <cstdio>
#include <cstdint>

#ifndef MK_PER_PHASE
#define MK_PER_PHASE 0
#endif

__device__ __forceinline__ int tid_of(int wv) { return wv * 64 + (int)__builtin_amdgcn_mbcnt_hi(~0u, __builtin_amdgcn_mbcnt_lo(~0u, 0u)); }
namespace pg8 {
#define PG8_LAS __attribute__((address_space(3)))
typedef unsigned short bf16_t;
typedef short bf16x8 __attribute__((ext_vector_type(8)));
typedef float f32x4 __attribute__((ext_vector_type(4)));
typedef unsigned u32x4 __attribute__((ext_vector_type(4)));
typedef int i32x4 __attribute__((ext_vector_type(4)));
typedef int i32x8 __attribute__((ext_vector_type(8)));
constexpr int BM = 256, BK = 64, HALF = 128, HTB = HALF * BK * 2, STAGE_BYTES = 8 * HTB, NXCD = 8, WGM = 8;

__host__ __device__ __forceinline__ int lds_byte(int r, int c) { const int st = (r >> 4) * 2 + (c >> 5), rr = r & 15, cc = c & 31, ob = rr * 64 + cc * 2; return st * 1024 + (ob ^ (((ob >> 9) & 1) << 5)); }
__host__ __device__ __forceinline__ void stage_rc(int b, int& R, int& C) { const int st = b / 1024, sb = b % 1024, swz = sb ^ (((sb >> 9) & 1) << 5); R = (st >> 1) * 16 + swz / 64; C = (st & 1) * 32 + (swz % 64) / 2; }
__host__ __device__ __forceinline__ int perm32(int rho) { const int n = rho >> 4, i = rho & 15; return 8 * (i >> 2) + 4 * n + (i & 3); }

struct Unit { int pm, pn, seg; };
struct Gemm { const bf16_t* A0; const bf16_t* A1; const bf16_t* B0; const bf16_t* B1; int lda, ldb, nt; int kstepB; size_t tileB; int nb; };
__host__ __device__ __forceinline__ Gemm gemm_tiledB(const bf16_t* A0, const bf16_t* A1, const bf16_t* B0, const bf16_t* B1, int lda, int K) { return Gemm{A0, A1, B0, B1, lda, 64, K / 64, 32768, (size_t)256 * K, 0}; }
__host__ __device__ __forceinline__ Gemm gemm_chunkB(const bf16_t* A0, const bf16_t* A1, const bf16_t* B0, const bf16_t* B1, int lda, int K, int) { return Gemm{A0, A1, B0, B1, lda, 0, K / 64, 32768, (size_t)256 * K, 256}; }
__host__ __device__ __forceinline__ Gemm gemm_chunkB8(const void* A, const void* B, int lda, int K, size_t tile_bytes = 0) { return Gemm{(const bf16_t*)A, (const bf16_t*)A, (const bf16_t*)B, (const bf16_t*)B, lda, 0, K / 128, 32768, tile_bytes ? tile_bytes / 2 : (size_t)128 * K, 256}; }
__host__ __device__ __forceinline__ Gemm gemm_rowB(const bf16_t* A0, const bf16_t* A1, const bf16_t* B0, const bf16_t* B1, int lda, int ldb, int K) { return Gemm{A0, A1, B0, B1, lda, ldb, K / 64, 128, (size_t)256 * ldb, 0}; }

struct StaticOrder {
    int nM, nN, nwg, G, c, pn0, gap_at, gap_len, ibeg, iend;
    __host__ __device__ void init(int M, int N, int G_, int c_, int pn0_ = 0, int gap_at_ = 1 << 30, int gap_len_ = 0) { nM = M / BM; nN = N / BM; nwg = nM * nN; G = G_; c = c_; pn0 = pn0_; gap_at = gap_at_; gap_len = gap_len_; ibeg = 0; iend = 1 << 30; }
    __host__ __device__ bool tile(long L, Unit& u) const {
        if (L >= nwg) return false;
        int wgid = (int)L; { const int q = nwg / NXCD, r = nwg % NXCD, xcd = wgid % NXCD, off = wgid / NXCD; wgid = (xcd < r ? xcd * (q + 1) : r * (q + 1) + (xcd - r) * q) + off; }
        const int nig = WGM * nN, gid = wgid / nig, fm = gid * WGM, gsz = (nM - fm) < WGM ? (nM - fm) : WGM;
        u.pm = fm + ((wgid % nig) % gsz); { const int p = (wgid % nig) / gsz; u.pn = pn0 + p + (p >= gap_at ? gap_len : 0); } return true;
    }
    __host__ __device__ bool next(int i, Unit& u) const { u.seg = 0; const int idx = ibeg + i; if (idx >= iend) return false; return tile((long)idx * G + c, u); }
};
struct StaticOrder2 : StaticOrder {
    __host__ __device__ bool next(int i, Unit& u) const { const bool ok = tile((long)(i >> 1) * G + c, u); u.seg = i & 1; return ok; }
};

typedef __bf16 bf16x2_t __attribute__((ext_vector_type(2)));
typedef float f32x2_t __attribute__((ext_vector_type(2)));
__device__ __forceinline__ unsigned cvt_pk_bf16(float lo, float hi) { const f32x2_t f = {lo, hi}; const bf16x2_t b = __builtin_convertvector(f, bf16x2_t); return __builtin_bit_cast(unsigned, b); }

template <int MODE, bool FP8> __device__ __forceinline__ const char* a_ptr(const Gemm& g, const Unit& u) {
    const bf16_t* A = (MODE == 1 && u.seg) ? g.A1 : g.A0; size_t off = (size_t)u.pm * BM * g.lda;
    return FP8 ? (const char*)A + off : (const char*)(A + off); }
template <int MODE> __device__ __forceinline__ const char* b_ptr(const Gemm& g, const Unit& u) {
    const bf16_t* B = (MODE == 1 && u.seg) ? g.B1 : g.B0; return (const char*)(B + (size_t)u.pn * g.tileB); }

template <class Epi, class Sched, int MODE, bool ALIGN_EPI, bool FP8 = false, bool I8 = false>
__device__ __forceinline__ void gemm_phase(PG8_LAS unsigned char* lds, const Gemm g, const Sched& S, const Epi& E, const int wv) {
    int tid_ = tid_of(wv); asm volatile("" : "+v"(tid_));
    const int tid = tid_, wid = __builtin_amdgcn_readfirstlane(tid >> 6), lane = tid & 63, wr = wid >> 2, wc = wid & 3, fr = lane & 15, fq = lane >> 4;
    const int nt = g.nt;
    constexpr bool CHB = true;
    unsigned voffA[2], voffB[2];
#pragma unroll
    for (int i = 0; i < 2; ++i) { int R, C; stage_rc(tid * 16 + i * 8192, R, C); const int Rb = Epi::PERM ? ((R & ~31) + perm32(R & 31)) : R;
        voffA[i] = (FP8 || I8) ? (unsigned)(R * g.lda + C * 2) : (unsigned)(R * g.lda + C) * 2u; voffB[i] = CHB ? (unsigned)((4 * i + (wid >> 1)) * 256 + (wid & 1) * 64 + lane) * 16u : (unsigned)(Rb * g.ldb + C) * 2u; }
    const size_t kstep = (size_t)(BK * 2), kstepB = (size_t)g.kstepB;
    const size_t hstepA = (size_t)HALF * g.lda * ((FP8 || I8) ? 1 : 2), hstepB = g.nb ? (size_t)HALF * 16 : (size_t)HALF * g.ldb * 2;
    unsigned voffAh[2], voffBh[2];
#pragma unroll
    for (int i = 0; i < 2; ++i) { voffAh[i] = voffA[i] + (unsigned)hstepA; voffBh[i] = voffB[i] + (unsigned)hstepB; }
    const unsigned ldsw = (unsigned)wid * 1024u;
    const int aoff = lds_byte(wr * 64 + fr, fq * 8), boff = CHB ? (fq * 128 + wc * 32 + fr) * 16 : lds_byte(wc * 32 + fr, fq * 8);
#define PG8_SA(b, h) (((b) * 2 + (h)) * HTB)
#define PG8_SB(b, h) ((4 + (b) * 2 + (h)) * HTB)
#define PG8_STAGE(bufoff, gbase, voff) do { _Pragma("unroll") for (int _i = 0; _i < 2; ++_i) \
        __builtin_amdgcn_global_load_lds((const unsigned*)((const char*)(gbase) + (voff)[_i]), (PG8_LAS unsigned*)(lds + (bufoff) + ldsw + _i * 8192), 16, 0, 0); } while (0)
#define PG8_LD16(p) (*(const PG8_LAS i32x4*)(p))
#define PG8_LDA(dst, b, h) do { if constexpr (FP8) { _Pragma("unroll") for (int m = 0; m < 4; ++m) dst##8[m] = __builtin_shufflevector(PG8_LD16(lds + PG8_SA(b, h) + aoff + m * 2048), PG8_LD16(lds + PG8_SA(b, h) + aoff + m * 2048 + 1024), 0, 1, 2, 3, 4, 5, 6, 7); } else { \
        _Pragma("unroll") for (int m = 0; m < 4; ++m) _Pragma("unroll") for (int k = 0; k < 2; ++k) dst[m][k] = *(const PG8_LAS bf16x8*)(lds + PG8_SA(b, h) + aoff + m * 2048 + k * 1024); } } while (0)
#define PG8_LDB(dst, b, h) do { if constexpr (FP8) { _Pragma("unroll") for (int n = 0; n < 2; ++n) dst##8[n] = __builtin_shufflevector(PG8_LD16(lds + PG8_SB(b, h) + boff + n * 256), PG8_LD16(lds + PG8_SB(b, h) + boff + n * 256 + 8192), 0, 1, 2, 3, 4, 5, 6, 7); } else { \
        _Pragma("unroll") for (int n = 0; n < 2; ++n) _Pragma("unroll") for (int k = 0; k < 2; ++k) dst[n][k] = *(const PG8_LAS bf16x8*)(lds + PG8_SB(b, h) + boff + n * (CHB ? 256 : 2048) + k * (CHB ? 8192 : 1024)); } } while (0)
#define PG8_MMA(ai, bj, At, Bt) do { __builtin_amdgcn_s_setprio(1); if constexpr (FP8) { _Pragma("unroll") for (int m = 0; m < 4; ++m) _Pragma("unroll") for (int n = 0; n < 2; ++n) \
        acc[ai][bj][m][n] = __builtin_amdgcn_mfma_scale_f32_16x16x128_f8f6f4(Bt##8[n], At##8[m], acc[ai][bj][m][n], 0, 0, 0, 0, 0, 0); } else { \
        _Pragma("unroll") for (int m = 0; m < 4; ++m) _Pragma("unroll") for (int n = 0; n < 2; ++n) _Pragma("unroll") for (int k = 0; k < 2; ++k) { \
        if constexpr (I8) acc[ai][bj][m][n] = __builtin_bit_cast(f32x4, __builtin_amdgcn_mfma_i32_16x16x64_i8(__builtin_bit_cast(i32x4, Bt[n][k]), __builtin_bit_cast(i32x4, At[m][k]), __builtin_bit_cast(i32x4, acc[ai][bj][m][n]), 0, 0, 0)); \
        else acc[ai][bj][m][n] = __builtin_amdgcn_mfma_f32_16x16x32_bf16(Bt[n][k], At[m][k], acc[ai][bj][m][n], 0, 0, 0); } } __builtin_amdgcn_s_setprio(0); } while (0)
#define PG8_WAIT_V(n) asm volatile("s_waitcnt vmcnt(" #n ")" ::: "memory")
#define PG8_WAIT_L(n) asm volatile("s_waitcnt lgkmcnt(" #n ")" ::: "memory")
#define PG8_BAR __builtin_amdgcn_s_barrier()
#define PG8_SCHED __builtin_amdgcn_sched_barrier(0)
    Unit cur, nxt; int ui = 0;
    if (!S.next(0, cur)) return;
    f32x4 acc[2][2][4][2];
#pragma unroll
    for (int a = 0; a < 2; ++a)
#pragma unroll
        for (int b = 0; b < 2; ++b)
#pragma unroll
            for (int m = 0; m < 4; ++m)
#pragma unroll
                for (int n = 0; n < 2; ++n) acc[a][b][m][n] = (f32x4){0.f, 0.f, 0.f, 0.f};
    bf16x8 At[4][2], B0[2][2], B1[2][2]; i32x8 At8[4], B08[2], B18[2];
    const char* cA = a_ptr<MODE, (FP8 || I8)>(g, cur); const char* cB = b_ptr<MODE>(g, cur);
    PG8_STAGE(PG8_SB(0, 0), cB, voffB); PG8_STAGE(PG8_SB(0, 1), cB, voffBh); PG8_STAGE(PG8_SA(0, 0), cA, voffA); PG8_STAGE(PG8_SA(0, 1), cA, voffAh);
    if (wr == 1) PG8_BAR;
    PG8_WAIT_V(2); PG8_BAR;
    PG8_STAGE(PG8_SB(1, 0), cB + kstepB, voffB); PG8_STAGE(PG8_SA(1, 0), cA + kstep, voffA); PG8_STAGE(PG8_SB(1, 1), cB + kstepB, voffBh);
    PG8_WAIT_V(6); PG8_BAR;
    for (;;) {
        const bool has_next = S.next(ui + 1, nxt);
        float rsv[8];
        if constexpr (Epi::HAS_RS) E.load_rs(cur, wr, fr, rsv);
        const char* nA = has_next ? a_ptr<MODE, (FP8 || I8)>(g, nxt) : cA; const char* nB = has_next ? b_ptr<MODE>(g, nxt) : cB;
#pragma nounroll
        for (int t = 0; t < nt; t += 2) {
            const bool last = (t == nt - 2);
            asm volatile("" : "+v"(voffA[0]), "+v"(voffA[1]), "+v"(voffB[0]), "+v"(voffB[1]), "+v"(voffAh[0]), "+v"(voffAh[1]), "+v"(voffBh[0]), "+v"(voffBh[1]));
            const char* a1 = cA + (size_t)(t + 1) * kstep;
            const char* a2 = last ? nA : cA + (size_t)(t + 2) * kstep; const char* b2 = last ? nB : cB + (size_t)(t + 2) * kstepB;
            const char* a3 = a2 + kstep; const char* b3 = b2 + kstepB;
            asm volatile("" : "+s"(a1), "+s"(a2), "+s"(a3), "+s"(b2), "+s"(b3));
            PG8_LDB(B0, 0, 0); PG8_LDB(B1, 0, 1); PG8_SCHED; PG8_LDA(At, 0, 0); PG8_STAGE(PG8_SA(1, 1), a1, voffAh);
            PG8_WAIT_V(8); PG8_WAIT_L(0); PG8_BAR; PG8_MMA(0, 0, At, B0); PG8_MMA(0, 1, At, B1); PG8_BAR; PG8_SCHED;
            PG8_LDA(At, 0, 1); PG8_STAGE(PG8_SB(0, 0), b2, voffB); PG8_STAGE(PG8_SB(0, 1), b2, voffBh); PG8_STAGE(PG8_SA(0, 0), a2, voffA);
            PG8_WAIT_V(8); PG8_WAIT_L(0); PG8_BAR; PG8_MMA(1, 0, At, B0); PG8_MMA(1, 1, At, B1); PG8_BAR; PG8_SCHED;
            PG8_LDB(B0, 1, 0); PG8_LDB(B1, 1, 1); PG8_SCHED; PG8_LDA(At, 1, 0); PG8_STAGE(PG8_SA(0, 1), a2, voffAh);
            PG8_WAIT_V(8); PG8_WAIT_L(0); PG8_BAR; PG8_MMA(0, 0, At, B0); PG8_MMA(0, 1, At, B1); PG8_BAR; PG8_SCHED;
            PG8_LDA(At, 1, 1); PG8_STAGE(PG8_SB(1, 0), b3, voffB); PG8_STAGE(PG8_SB(1, 1), b3, voffBh); PG8_STAGE(PG8_SA(1, 0), a3, voffA);
            PG8_WAIT_V(8); PG8_WAIT_L(0); PG8_BAR; PG8_MMA(1, 0, At, B0); PG8_MMA(1, 1, At, B1); PG8_BAR; PG8_SCHED;
        }
        if constexpr (ALIGN_EPI) { if (wr == 0) PG8_BAR; }
        { int te = tid_of(wv); asm volatile("" : "+v"(te)); const int fre = te & 15, fqe = (te & 63) >> 4;
          if constexpr (Epi::HAS_RS) E(acc, cur, wr, wc, fre, fqe, rsv); else E(acc, cur, wr, wc, fre, fqe); }
        if (!has_next) break;
        if (!(MODE == 1 && cur.seg == 0)) {
#pragma unroll
        for (int a = 0; a < 2; ++a)
#pragma unroll
            for (int b = 0; b < 2; ++b)
#pragma unroll
                for (int m = 0; m < 4; ++m)
#pragma unroll
                    for (int n = 0; n < 2; ++n) acc[a][b][m][n] = (f32x4){0.f, 0.f, 0.f, 0.f};
        }
        cur = nxt; cA = nA; cB = nB; ++ui;
        if constexpr (ALIGN_EPI) { if (wr == 1) PG8_BAR; }
    }
    PG8_WAIT_V(0);
    if constexpr (!ALIGN_EPI) { if (wr == 0) PG8_BAR; }
    PG8_BAR;
#undef PG8_SA
#undef PG8_SB
#undef PG8_STAGE
#undef PG8_LDA
#undef PG8_LDB
#undef PG8_MMA
#undef PG8_WAIT_V
#undef PG8_WAIT_L
#undef PG8_BAR
#undef PG8_SCHED
}
}


namespace att {
constexpr int D = 128, LD = 2048;
constexpr float SCALE = 0.08838834764831845f, THR = 8.f;
constexpr bool WSKIP = false;
constexpr int NW = 8, QBLK = 32, KVBLK = 64, QB = NW * QBLK;
constexpr int SHM_V = KVBLK * D * 2, SHM_K = KVBLK * D * 2;
constexpr int LDS_BYTES = 2 * SHM_V + 2 * SHM_K + NW * 64 * 4;
typedef short bf16x8 __attribute__((ext_vector_type(8)));
typedef short s16x4 __attribute__((ext_vector_type(4)));
typedef float f32x16 __attribute__((ext_vector_type(16)));
typedef float f32x4 __attribute__((ext_vector_type(4)));
typedef unsigned u32x4 __attribute__((ext_vector_type(4)));
template <class A, class Bt> struct same_t { static constexpr bool v = false; };
template <class A> struct same_t<A, A> { static constexpr bool v = true; };
#define KSWZ(row, colB) ((row) * 256 + ((colB) ^ (((row) & 7) << 4)))
#define SBAR() __builtin_amdgcn_sched_barrier(0)
__device__ __forceinline__ int v_st(int k, int c) { const int kk = (k & ~0xC) | ((k & 4) << 1) | ((k & 8) >> 1); return ((kk >> 3) * 4 + (c >> 5)) * 512 + ((kk & 7) * 32 + (c & 31)) * 2; }
__device__ __forceinline__ int v_rd_base(int lane) { return ((lane & 3) << 3) | (((lane >> 2) & 3) << 6) | (((lane >> 4) & 1) << 5) | (((lane >> 5) & 1) << 8); }
constexpr int v_rd_off(int d0, int ks, int half) { return d0 * 512 + ks * 4096 + half * 2048; }
__device__ __forceinline__ int crow(int r, int hi) { return (r & 3) + 8 * (r >> 2) + 4 * hi; }
__device__ __forceinline__ unsigned cvtpk(float lo, float hi) { return pg8::cvt_pk_bf16(lo, hi); }
__device__ __forceinline__ bf16x8 pack8(f32x4 a, f32x4 b) {
    u32x4 w = {cvtpk(a[0], a[1]), cvtpk(a[2], a[3]), cvtpk(b[0], b[1]), cvtpk(b[2], b[3])};
    return *reinterpret_cast<bf16x8*>(&w);
}
template <class T> __device__ __forceinline__ bf16x8 load8(const T* p) {
    if constexpr (same_t<T, float>::v) { return pack8(*(const f32x4*)p, *(const f32x4*)(p + 4)); }
    else { return *reinterpret_cast<const bf16x8*>(p); }
}
__device__ __forceinline__ void mask_tile(f32x16& p0, f32x16& p1, int dq, unsigned W) {
    const float NEG = -__builtin_inff();
#pragma unroll
    for (int r = 0; r < 16; ++r) {
        const int c = (r & 3) + 8 * (r >> 2);
        if ((unsigned)(dq - c) >= W) p0[r] = NEG;
        if ((unsigned)(dq - c - 32) >= W) p1[r] = NEG;
    }
}
__device__ __forceinline__ void partialSM(f32x16& p0, f32x16& p1, float& m_reg, float& mn, float& alpha) {
    float pmax = p0[0]; for (int r = 1; r < 16; ++r) pmax = fmaxf(pmax, p0[r]); for (int r = 0; r < 16; ++r) pmax = fmaxf(pmax, p1[r]);
    { auto rr = __builtin_amdgcn_permlane32_swap(__float_as_uint(pmax), __float_as_uint(pmax), false, false);
      pmax = fmaxf(__uint_as_float(rr[0]), __uint_as_float(rr[1])); }
    constexpr float C2 = 1.4426950408889634f * SCALE;
    if (__builtin_expect(__all((pmax - m_reg) * SCALE <= THR), 1)) { mn = m_reg; alpha = 1.f; }
    else { mn = fmaxf(m_reg, pmax); alpha = __builtin_amdgcn_exp2f((m_reg - mn) * C2); m_reg = mn; }
    const float mnL = -mn * C2;
    for (int r = 0; r < 16; ++r) p0[r] = fmaf(p0[r], C2, mnL); for (int r = 0; r < 16; ++r) p1[r] = fmaf(p1[r], C2, mnL);
    for (int r = 0; r < 16; ++r) p0[r] = __builtin_amdgcn_exp2f(p0[r]);
}
__device__ __forceinline__ void finishSM(f32x16& p0, f32x16& p1, float alpha, float& l_reg, bf16x8& pa0, bf16x8& pa1, bf16x8& pa2, bf16x8& pa3) {
    for (int r = 0; r < 16; ++r) p1[r] = __builtin_amdgcn_exp2f(p1[r]);
    float ps = 0; for (int r = 0; r < 16; ++r) ps += p0[r]; for (int r = 0; r < 16; ++r) ps += p1[r];
    { auto rr = __builtin_amdgcn_permlane32_swap(__float_as_uint(ps), __float_as_uint(ps), false, false);
      ps = __uint_as_float(rr[0]) + __uint_as_float(rr[1]); }
    l_reg = l_reg * alpha + ps;
#define PK4(P, B_, OUT) do { unsigned a0 = cvtpk(P[B_+0], P[B_+1]), a1 = cvtpk(P[B_+2], P[B_+3]);                          \
        unsigned b0 = cvtpk(P[B_+4], P[B_+5]), b1 = cvtpk(P[B_+6], P[B_+7]);                                             \
        auto r0 = __builtin_amdgcn_permlane32_swap(a0, b0, false, false); auto r1 = __builtin_amdgcn_permlane32_swap(a1, b1, false, false); \
        u32x4 w = {r0[0], r1[0], r0[1], r1[1]}; OUT = *reinterpret_cast<bf16x8*>(&w); } while (0)
    PK4(p0, 0, pa0); PK4(p0, 8, pa1); PK4(p1, 0, pa2); PK4(p1, 8, pa3);
#undef PK4
}
template <int KB, bool SK>
__device__ __forceinline__ void qkt(f32x16& p0, f32x16& p1, const char* K_lds, int r32, int hi, const bf16x8* qr, bool act) {
    if (SK && !act) { const float NEG = -__builtin_inff();
#pragma unroll
        for (int r = 0; r < 16; ++r) { p0[r] = NEG; p1[r] = NEG; } return; }
    p0 = f32x16{}; p1 = f32x16{};
    const char* kb[4];
#pragma unroll
    for (int dd = 0; dd < 4; ++dd) kb[dd] = K_lds + KB * SHM_K + KSWZ(r32, (dd * 16 + hi * 8) * 2);
#pragma unroll
    for (int d0 = 0; d0 < 8; ++d0) { const char* a = kb[d0 & 3] + (d0 >> 2) * 128;
        bf16x8 b0 = *reinterpret_cast<const bf16x8*>(a);
        bf16x8 b1 = *reinterpret_cast<const bf16x8*>(a + 32 * 256);
        p0 = __builtin_amdgcn_mfma_f32_32x32x16_bf16(b0, qr[d0], p0, 0, 0, 0);
        p1 = __builtin_amdgcn_mfma_f32_32x32x16_bf16(b1, qr[d0], p1, 0, 0, 0); }
}
template <int VB, bool SK>
__device__ __forceinline__ void pv_tile(f32x16* o, int vb0, bf16x8 pa0, bf16x8 pa1, bf16x8 pa2, bf16x8 pa3, bool act) {
    if (SK && !act) return;
#define TRRD(dst, off) asm volatile("ds_read_b64_tr_b16 %0, %1 offset:%2" : "=&v"(dst) : "v"(vb0), "i"(off) : "memory")
#define PV_D0(d0) do { s16x4 l0, l1, l2, l3, h0, h1, h2, h3; constexpr int b_ = VB * SHM_V + v_rd_off(d0, 0, 0);     \
        TRRD(l0, b_); TRRD(h0, b_ + 2048); TRRD(l1, b_ + 4096); TRRD(h1, b_ + 6144); TRRD(l2, b_ + 8192); TRRD(h2, b_ + 10240); TRRD(l3, b_ + 12288); TRRD(h3, b_ + 14336); \
        asm volatile("s_waitcnt lgkmcnt(0)" ::: "memory"); SBAR();                 \
        o[d0] = __builtin_amdgcn_mfma_f32_32x32x16_bf16(pa0, (bf16x8){l0[0], l0[1], l0[2], l0[3], h0[0], h0[1], h0[2], h0[3]}, o[d0], 0, 0, 0);   \
        o[d0] = __builtin_amdgcn_mfma_f32_32x32x16_bf16(pa1, (bf16x8){l1[0], l1[1], l1[2], l1[3], h1[0], h1[1], h1[2], h1[3]}, o[d0], 0, 0, 0);   \
        o[d0] = __builtin_amdgcn_mfma_f32_32x32x16_bf16(pa2, (bf16x8){l2[0], l2[1], l2[2], l2[3], h2[0], h2[1], h2[2], h2[3]}, o[d0], 0, 0, 0);   \
        o[d0] = __builtin_amdgcn_mfma_f32_32x32x16_bf16(pa3, (bf16x8){l3[0], l3[1], l3[2], l3[3], h3[0], h3[1], h3[2], h3[3]}, o[d0], 0, 0, 0); } while (0)
    PV_D0(0); PV_D0(1); PV_D0(2); PV_D0(3);
#undef PV_D0
#undef TRRD
}

template <class TIn, class TOut> struct BlockRef { const TIn* Q; const TIn* K; const TIn* V; TOut* O; int P0; };
template <class TIn> struct Seam {
    bf16x8 qr[8];
    bf16x8 st_v0, st_v1, st_k0, st_k1; f32x4 sf0, sf1, sf2, sf3;
    f32x4 tq[16];
};
__device__ __forceinline__ int swa_jlo(int P0, int W) { const int lowk = P0 - W + 1; return lowk > 0 ? lowk / KVBLK : 0; }
#define ROW(p, k0, rr) ((p) + (unsigned)(((k0) + (rr)) * LD + sc))
#define VMW() asm volatile("s_waitcnt vmcnt(0)" ::: "memory")
#define VMWN(n) asm volatile("s_waitcnt vmcnt(%0)" :: "i"(n) : "memory")
#define SLOAD_H(Kp, Vp, k0) do { S.st_v0 = load8<TIn>(ROW(Vp, k0, sr)); S.st_v1 = load8<TIn>(ROW(Vp, k0, 32 + sr));              \
                         S.st_k0 = load8<TIn>(ROW(Kp, k0, sr)); S.st_k1 = load8<TIn>(ROW(Kp, k0, 32 + sr)); } while (0)
#define SWRITE_HK(bf) do { *(bf16x8*)(K_lds + (bf) * SHM_K + kws) = S.st_k0; *(bf16x8*)(K_lds + (bf) * SHM_K + kws + 32 * 256) = S.st_k1; } while (0)
#define SWRITE_HV(bf) do { *(bf16x8*)(V_lds + (bf) * SHM_V + vst0) = S.st_v0; *(bf16x8*)(V_lds + (bf) * SHM_V + vst1) = S.st_v1; } while (0)
#define SWRITE_H(bf) do { SWRITE_HV(bf); SWRITE_HK(bf); } while (0)
#define SLOAD_F(p, k0) do { S.sf0 = *(const f32x4*)ROW(p, k0, sr); S.sf1 = *(const f32x4*)(ROW(p, k0, sr) + 4);                \
                            S.sf2 = *(const f32x4*)ROW(p, k0, 32 + sr); S.sf3 = *(const f32x4*)(ROW(p, k0, 32 + sr) + 4); } while (0)
#define SWRITE_KF(bf) do { *(bf16x8*)(K_lds + (bf) * SHM_K + kws) = pack8(S.sf0, S.sf1); *(bf16x8*)(K_lds + (bf) * SHM_K + kws + 32 * 256) = pack8(S.sf2, S.sf3); } while (0)
#define SWRITE_VF(bf) do { *(bf16x8*)(V_lds + (bf) * SHM_V + vst0) = pack8(S.sf0, S.sf1); *(bf16x8*)(V_lds + (bf) * SHM_V + vst1) = pack8(S.sf2, S.sf3); } while (0)
template <class TIn, class TOut>
__device__ __forceinline__ void causal_swa_prime(const BlockRef<TIn, TOut>& cur, int W, char* lds, Seam<TIn>& S, const int wv) {
    constexpr bool F32 = same_t<TIn, float>::v;
    const int tid = tid_of(wv), wid = __builtin_amdgcn_readfirstlane(tid >> 6), lane = tid & 63, r32 = lane & 31, hi = lane >> 5;
    const int sr = tid >> 4, sc = (tid & 15) * 8, kws = KSWZ(sr, sc * 2); char* K_lds = lds + 2 * SHM_V;
    const int kb0 = swa_jlo(cur.P0, W) * KVBLK;
    for (int d0 = 0; d0 < 8; ++d0) S.qr[d0] = load8<TIn>(cur.Q + (unsigned)((wid * QBLK + r32) * LD + d0 * 16 + hi * 8));
    if constexpr (F32) { SLOAD_F((const float*)cur.K, kb0); VMW(); SWRITE_KF(0); SBAR(); SLOAD_F((const float*)cur.V, kb0); }
    else { SLOAD_H(cur.K, cur.V, kb0); VMW(); SWRITE_HK(0); }
    __syncthreads();
}
template <class TIn, class TOut>
__device__ __forceinline__ void causal_swa_block(const BlockRef<TIn, TOut>& cur, const BlockRef<TIn, TOut>& nxt, int skv, int W, char* lds, Seam<TIn>& S, const __attribute__((address_space(3))) unsigned char* rowmask, const int wv) {
    constexpr bool F32 = same_t<TIn, float>::v;
    const int tid = tid_of(wv), wid = __builtin_amdgcn_readfirstlane(tid >> 6), lane = tid & 63, r32 = lane & 31, hi = lane >> 5;
    const int j_lo = swa_jlo(cur.P0, W);
    int j_hi = (cur.P0 + QB - 1) / KVBLK + 1; if (j_hi > skv / KVBLK) j_hi = skv / KVBLK;
    const int NT = j_hi - j_lo;
    const int kbn = swa_jlo(nxt.P0, W) * KVBLK;
    const int qlo = cur.P0 + wid * QBLK, qm = qlo + r32 - 4 * hi;
    char* V_lds = lds; char* K_lds = lds + 2 * SHM_V;
    float* ws = (float*)(lds + 2 * SHM_V + 2 * SHM_K) + wid * 64; float* li_l = ws, * al_l = ws + 32;
    float m_reg = -1e30f, l_reg = 0; f32x16 o[4] = {};
    const int sr = tid >> 4, sc = (tid & 15) * 8, vst0 = v_st(sr, sc), vst1 = v_st(32 + sr, sc), kws = KSWZ(sr, sc * 2);
    const int vb0 = (int)(uintptr_t)V_lds + v_rd_base(lane);
    const TIn* Kh = cur.K; const TIn* Vh = cur.V;
#define RESC(a) do { if (__any((a) < 1.f)) { if (hi == 0) al_l[r32] = (a); asm volatile("s_waitcnt lgkmcnt(0)" ::: "memory");              \
                     for (int d_ = 0; d_ < 4; ++d_) for (int r = 0; r < 16; ++r) o[d_][r] *= al_l[crow(r, hi)]; } } while (0)
#define KBASE(t) ((j_lo + (t)) * KVBLK)
#define ACT(t) (KBASE(t) <= qlo + QBLK - 1 && KBASE(t) + KVBLK - 1 >= qlo - W + 1)
#define MASKT(P0_, P1_, t) do { const int kb_ = KBASE(t); \
        if (kb_ < cur.P0) { const bool keep_ = (((unsigned)rowmask[wid * QBLK + r32] >> (kb_ >> 8)) & 1u) != 0u; if (!__all(keep_)) { const float NEG_ = -__builtin_inff(); \
            _Pragma("unroll") for (int r_ = 0; r_ < 16; ++r_) { P0_[r_] = keep_ ? P0_[r_] : NEG_; P1_[r_] = keep_ ? P1_[r_] : NEG_; } } } \
        else if (kb_ + KVBLK - 1 > qlo) mask_tile(P0_, P1_, qm - kb_, (unsigned)W); } while (0)
    constexpr int NQL = F32 ? 16 : 8;
    constexpr bool SK = WSKIP && !F32;
#define SEAM_K0() do { VMWN(NQL); if constexpr (F32) { SWRITE_KF(0); SBAR(); SLOAD_F((const float*)nxt.V, kbn); } else { SWRITE_HK(0); } SBAR(); } while (0)
    f32x16 pA0, pA1, pB0, pB1; float mnA, mnB, alA, alB; bf16x8 pa0, pa1, pa2, pa3;
    if constexpr (F32) { VMW(); SWRITE_VF(0); SBAR(); } else { SWRITE_HV(0); SBAR(); }
    if (NT > 1) { if constexpr (F32) SLOAD_F((const float*)Kh, KBASE(1)); else SLOAD_H(Kh, Vh, KBASE(1)); }
    SBAR(); qkt<0, SK>(pA0, pA1, K_lds, r32, hi, S.qr, ACT(0));
    if constexpr (F32) { if (NT > 1) { VMW(); SWRITE_KF(1); SBAR(); SLOAD_F((const float*)Vh, KBASE(1)); } }
    MASKT(pA0, pA1, 0); partialSM(pA0, pA1, m_reg, mnA, alA);
    if (NT > 1) { VMW(); if constexpr (F32) { SWRITE_VF(1); SBAR(); if (NT > 2) SLOAD_F((const float*)Kh, KBASE(2)); } else SWRITE_H(1); }
    __syncthreads();
#define HALF_STEP(PX0, PX1, mnX, alX, PY0, PY1, alY, t, KB, VB, SB) do {                                                      \
        SBAR(); qkt<KB, SK>(PX0, PX1, K_lds, r32, hi, S.qr, ACT(t));                                             \
        finishSM(PY0, PY1, alY, l_reg, pa0, pa1, pa2, pa3); SBAR();                                                           \
        if ((t) + 1 < NT) { if constexpr (F32) { VMW(); SWRITE_KF(SB); SBAR(); SLOAD_F((const float*)Vh, KBASE((t) + 1)); }  \
                            else { SLOAD_H(Kh, Vh, KBASE((t) + 1)); } SBAR(); }                                               \
        pv_tile<VB, SK>(o, vb0, pa0, pa1, pa2, pa3, ACT((t) - 1)); MASKT(PX0, PX1, (t)); partialSM(PX0, PX1, m_reg, mnX, alX);                                        \
        __syncthreads();                                                                                                      \
        if ((t) + 1 < NT) { VMW(); if constexpr (F32) { SWRITE_VF(SB); SBAR(); if ((t) + 2 < NT) SLOAD_F((const float*)Kh, KBASE((t) + 2)); } \
                            else { SWRITE_H(SB); } }                                                                          \
        RESC(alX); __syncthreads(); } while (0)
    for (int t = 1; t + 1 < NT; t += 2) {
        HALF_STEP(pB0, pB1, mnB, alB, pA0, pA1, alA, t, 1, 0, 0);
        HALF_STEP(pA0, pA1, mnA, alA, pB0, pB1, alB, t + 1, 0, 1, 1);
    }
    const bool even = (NT & 1) == 0;
    if (even) { SBAR(); qkt<1, SK>(pB0, pB1, K_lds, r32, hi, S.qr, ACT(NT - 1)); SBAR(); }
#define QROW(e) (nxt.Q + (size_t)(wid * QBLK + r32) * LD + ((e) >> 1) * 16 + hi * 8 + ((e) & 1) * 4)
    if constexpr (F32) { SLOAD_F((const float*)nxt.K, kbn); SBAR();
#pragma unroll
        for (int e = 0; e < 8; ++e) S.tq[e] = *(const f32x4*)QROW(e); }
    else { SLOAD_H(nxt.K, nxt.V, kbn); SBAR();
#pragma unroll
        for (int d0 = 0; d0 < 8; ++d0) S.qr[d0] = load8<TIn>(nxt.Q + (unsigned)((wid * QBLK + r32) * LD + d0 * 16 + hi * 8)); }
    SBAR();
    finishSM(pA0, pA1, alA, l_reg, pa0, pa1, pa2, pa3); SBAR();
    if constexpr (F32) {
#pragma unroll
        for (int e = 8; e < 16; ++e) S.tq[e] = *(const f32x4*)QROW(e); SBAR(); }
#undef QROW
    pv_tile<0, SK>(o, vb0, pa0, pa1, pa2, pa3, ACT(even ? NT - 2 : NT - 1));
    if (even) { MASKT(pB0, pB1, NT - 1); partialSM(pB0, pB1, m_reg, mnB, alB); __syncthreads(); RESC(alB);
        finishSM(pB0, pB1, alB, l_reg, pa0, pa1, pa2, pa3); SBAR(); pv_tile<1, SK>(o, vb0, pa0, pa1, pa2, pa3, ACT(NT - 1)); }
    SBAR(); SEAM_K0();
    if (hi == 0) li_l[r32] = l_reg; asm volatile("s_waitcnt lgkmcnt(0)" ::: "memory");
    float rli[16];
#pragma unroll
    for (int r = 0; r < 16; ++r) rli[r] = __builtin_amdgcn_rcpf(li_l[crow(r, hi)]);
    TOut* Ow = cur.O + (size_t)(wid * QBLK) * LD;
#pragma unroll
    for (int r = 0; r < 16; ++r) { const int orow = crow(r, hi);
#pragma unroll
        for (int d0 = 0; d0 < 4; ++d0) { const float v = o[d0][r] * rli[r];
            if constexpr (same_t<TOut, float>::v) { Ow[(size_t)orow * LD + d0 * 32 + r32] = v; }
            else { const float vn = __shfl_xor(v, 1);
                   if ((r32 & 1) == 0) *(unsigned*)(Ow + (unsigned)(orow * LD + d0 * 32 + r32)) = cvtpk(v, vn); } } }
    if constexpr (F32) {
#pragma unroll
        for (int d0 = 0; d0 < 8; ++d0) S.qr[d0] = pack8(S.tq[2 * d0], S.tq[2 * d0 + 1]); }
    __syncthreads();
#undef RESC
#undef KBASE
#undef ACT
#undef MASKT
#undef SEAM_K0
#undef HALF_STEP
}
#undef ROW
#undef VMW
#undef VMWN
#undef SLOAD_H
#undef SWRITE_HK
#undef SWRITE_HV
#undef SWRITE_H
#undef SLOAD_F
#undef SWRITE_KF
#undef SWRITE_VF

}

constexpr int NB = 4, SEQ = 2048, DM = 4096, M = NB * SEQ;
constexpr int NH = 16, HD = 128, AW = 2048, LW = 2048, FF = 11008, INC = 18432;
constexpr int MOBA_BLK = 256, MOBA_TOPK = 3;
constexpr float EPS = 1e-6f;

constexpr size_t MiB = 1u << 20;
constexpr size_t WS_CTL = 0, CTL_ZERO_BYTES = 1 * MiB;
constexpr size_t WS_ROPE = 1 * MiB;
constexpr size_t WS_KM = 2 * MiB;
constexpr size_t WS_SP = 2 * MiB + 512 * 1024;
constexpr size_t WS_RS = 2 * MiB + 512 * 1024 + 64 * 1024;
constexpr size_t WS_WGU1 = 8 * MiB;
constexpr size_t WS_WD1 = WS_WGU1 + 172 * MiB;
constexpr size_t WS_WIN = WS_WD1 + 86 * MiB;
constexpr size_t WS_WAO = WS_WIN + 144 * MiB;
constexpr size_t WS_WRO = WS_WAO + 16 * MiB;
constexpr size_t WS_WO = WS_WRO + 16 * MiB;
constexpr size_t WS_WGU2 = WS_WO + 32 * MiB;
constexpr size_t WS_WD2 = WS_WGU2 + 172 * MiB;
constexpr size_t WS_ACT = WS_WD2 + 86 * MiB;
constexpr size_t WS_H = WS_ACT + 64 * MiB;
constexpr size_t WS_F = WS_H + 172 * MiB;
constexpr size_t WS_XR = WS_F + 128 * MiB;
constexpr size_t WS_MG = WS_XR + 128 * MiB;
constexpr size_t WS_END = WS_MG + 64 * MiB;
static_assert(WS_END <= 1500 * MiB, "workspace map");
constexpr int CW_BAR = 4096;

constexpr int RING_OFF = 0, RING_BYTES = 131072;
constexpr int MISC_OFF = RING_BYTES;
constexpr int LDS_BYTES = 147456;
constexpr int NWAVES = 8, NTHR = 512;

#define GAS __attribute__((address_space(1)))
#define LAS __attribute__((address_space(3)))
typedef unsigned short bf16;
typedef unsigned v4u __attribute__((ext_vector_type(4)));
typedef unsigned v2u __attribute__((ext_vector_type(2)));
typedef float f32x4 __attribute__((ext_vector_type(4)));
typedef float f32x2 __attribute__((ext_vector_type(2)));
#define LDS_WAIT() asm volatile("s_waitcnt lgkmcnt(0)" ::: "memory")
#define VM_WAIT() asm volatile("s_waitcnt vmcnt(0)" ::: "memory")
__device__ __forceinline__ unsigned f2bf(float f) { unsigned u = __builtin_bit_cast(unsigned, f); return (u + 0x7fffu + ((u >> 16) & 1u)) >> 16; }
__device__ __forceinline__ unsigned pk2(float lo, float hi) { return f2bf(lo) | (f2bf(hi) << 16); }
__device__ __forceinline__ float bflo(unsigned w) { return __builtin_bit_cast(float, w << 16); }
__device__ __forceinline__ float bfhi(unsigned w) { return __builtin_bit_cast(float, w & 0xffff0000u); }
__device__ __forceinline__ float sigmoidf_(float x) { return __builtin_amdgcn_rcpf(1.f + __expf(-x)); }
__device__ __forceinline__ float gelu_tanh(float x) { const float z = 1.5957691216057308f * (x + 0.044715f * x * x * x); return x * sigmoidf_(z); }
__device__ __forceinline__ float one_minus_exp(float x) {
    const float p = -x * (1.f + x * (0.5f + x * (0.16666667f + x * (0.041666668f + x * (0.0083333338f + x * 0.0013888889f)))));
    return x > -0.3f ? p : 1.f - __expf(x);
}
__device__ __forceinline__ float wave_sum(float v) {
#pragma unroll
    for (int o = 1; o < 64; o <<= 1) v += __shfl_xor(v, o);
    return v;
}
__device__ __forceinline__ float wave_max(float v) {
#pragma unroll
    for (int o = 1; o < 64; o <<= 1) v = fmaxf(v, __shfl_xor(v, o));
    return v;
}

#define XB_TMO      128
#define XB_XCNT(j)  (256  + 64 * (j))
#define XB_XSUB(j)  (1280 + 64 * (j))
#define XB_XGEN(j)  (2304 + 64 * (j))
#define XB_TOP      3328
#define XB_TOPGEN   3392
#define XCD_BAR_WORDS 3456
#define XB_SPIN_CAP (1u << 18)
__device__ __forceinline__ unsigned xb_ld(unsigned* p)              { return __hip_atomic_load(p, __ATOMIC_RELAXED, __HIP_MEMORY_SCOPE_AGENT); }
__device__ __forceinline__ unsigned xb_add(unsigned* p, unsigned v) { return __hip_atomic_fetch_add(p, v, __ATOMIC_RELAXED, __HIP_MEMORY_SCOPE_AGENT); }
__device__ __forceinline__ unsigned xb_xcc_id() { return (unsigned)__builtin_amdgcn_s_getreg((3 << 11) | 20) & 0xFu; }
#define XB_SPIN(cond, bar) do { unsigned _sp = 0; while (cond) { __builtin_amdgcn_s_sleep(1); \
    if ((++_sp & 255u) == 0u) { if (xb_ld(&(bar)[XB_TMO])) break; if (_sp > XB_SPIN_CAP) { atomicAdd(&(bar)[XB_TMO], 1u); break; } } } } while (0)
struct XcdBarrier { unsigned* bar; unsigned x; volatile LAS unsigned* st; int wv; };
__device__ __forceinline__ XcdBarrier xcd_barrier_post(unsigned* bar, volatile LAS unsigned* st, int wv) {
    XcdBarrier b; b.bar = bar; b.x = xb_xcc_id(); b.st = st; b.wv = wv;
    if (tid_of(wv) == 0) (void)xb_add(&bar[XB_XCNT(b.x)], 1u);
    return b;
}
__device__ __forceinline__ void xcd_barrier_complete(unsigned* bar, unsigned x, unsigned& nloc, unsigned& nx) {
    const unsigned G = gridDim.x * gridDim.y * gridDim.z;
    unsigned sum, cnt, mine, sp = 0u;
    for (;;) {
        sum = 0u; cnt = 0u; mine = 0u;
#pragma unroll
        for (unsigned j = 0; j < 16; ++j) { const unsigned c = xb_ld(&bar[XB_XCNT(j)]); sum += c; cnt += (c > 0u) ? 1u : 0u; mine = (j == x) ? c : mine; }
        if (sum == G) break;
        __builtin_amdgcn_s_sleep(1);
        if ((++sp & 255u) == 0u) { if (xb_ld(&bar[XB_TMO])) break; if (sp > XB_SPIN_CAP) { atomicAdd(&bar[XB_TMO], 1u); break; } }
    }
    nloc = mine > 0u ? mine : 1u; nx = cnt > 0u ? cnt : 1u;
}
__device__ __forceinline__ void xcd_barrier(const XcdBarrier& b) {
    asm volatile("s_waitcnt vmcnt(0)" ::: "memory");
    __syncthreads();
    if (tid_of(b.wv) == 0) {
        unsigned* bar = b.bar;
        __builtin_amdgcn_s_waitcnt(0);
        unsigned nloc = b.st[0], nx = b.st[1];
        if (nloc == 0u) { xcd_barrier_complete(bar, b.x, nloc, nx); b.st[0] = nloc; b.st[1] = nx; }
        const unsigned old = xb_add(&bar[XB_XSUB(b.x)], 1u);
        const unsigned gen = old / nloc;
        if (old + 1u == (gen + 1u) * nloc) {
            __builtin_amdgcn_fence(__ATOMIC_RELEASE, "agent");
            asm volatile("s_waitcnt vmcnt(0)" ::: "memory");
            const unsigned og = xb_add(&bar[XB_TOP], 1u);
            const unsigned tg = og / nx;
            if (og + 1u == (tg + 1u) * nx) xb_add(&bar[XB_TOPGEN], 1u);
            else XB_SPIN(xb_ld(&bar[XB_TOPGEN]) == tg, bar);
            __builtin_amdgcn_fence(__ATOMIC_ACQUIRE, "agent");
            xb_add(&bar[XB_XGEN(b.x)], 1u);
            asm volatile("s_waitcnt vmcnt(0)" ::: "memory");
        } else {
            XB_SPIN(xb_ld(&bar[XB_XGEN(b.x)]) == gen, bar);
            __builtin_amdgcn_fence(__ATOMIC_ACQUIRE, "agent");
            asm volatile("s_waitcnt vmcnt(0)" ::: "memory");
        }
    }
    __syncthreads();
}

using pg8::Unit; using pg8::HALF; using pg8::BM; using pg8::cvt_pk_bf16;
typedef pg8::f32x4 (AccT)[2][2][4][2];

constexpr float WGI_SCALE = 2111.f;
__device__ __forceinline__ unsigned pk4_i8(float a, float b, float c, float d) {
    unsigned w = __builtin_amdgcn_cvt_pk_u8_f32(a + 128.f, 0, 0u); w = __builtin_amdgcn_cvt_pk_u8_f32(b + 128.f, 1, w);
    w = __builtin_amdgcn_cvt_pk_u8_f32(c + 128.f, 2, w); w = __builtin_amdgcn_cvt_pk_u8_f32(d + 128.f, 3, w); return w ^ 0x80808080u; }
constexpr int F8T = 48;
constexpr float X8_SCALE = 32.f, WG8_SCALE = 64.f;
constexpr float H8_SCALE = 8.f, W8_SCALE = 128.f;
__device__ __forceinline__ unsigned pk4_fp8(float a, float b, float c, float d) {
    int w = __builtin_amdgcn_cvt_pk_fp8_f32(a, b, 0, false); w = __builtin_amdgcn_cvt_pk_fp8_f32(c, d, w, true); return (unsigned)w; }
constexpr float HQ_SCALE = 127.f / (5.f * 5.656854f * 0.6f);
constexpr float WQ_SCALE = 127.f / (3.85f * 5.656854f * 0.0095311f);
constexpr float DQ_SCALE = 1.f / (HQ_SCALE * WQ_SCALE * 32.f);
template <int HF, bool RSV = true, bool IACC = false>
struct EpiSwiGLU {
    static constexpr bool PERM = true, HAS_RS = RSV;
    bf16* H; const float* RSc; float sc;
    __device__ __forceinline__ void load_rs(const Unit& u, int wr, int fr, float (&rsv)[8]) const {
#pragma unroll
        for (int i = 0; i < 8; ++i) rsv[i] = RSc[u.pm * BM + wr * 64 + fr + (i >> 2) * HALF + (i & 3) * 16] * sc; }
    __device__ __forceinline__ void operator()(AccT& acc, const Unit& u, int wr, int wc, int fr, int fq) const {
        const float rsc[8] = {sc, sc, sc, sc, sc, sc, sc, sc}; (*this)(acc, u, wr, wc, fr, fq, rsc); }
    __device__ __forceinline__ void operator()(AccT& acc, const Unit& u, int wr, int wc, int fr, int fq, const float (&rsv)[8]) const {
        const int row0 = u.pm * BM + wr * 64 + fr, col0 = u.pn * HALF + wc * 32 + 8 * fq;
#pragma unroll
        for (int ai = 0; ai < 2; ++ai)
#pragma unroll
            for (int m = 0; m < 4; ++m) {
                float o[8]; const float rs = rsv[ai * 4 + m];
                if constexpr (HF == 2) {
                    typedef float f2 __attribute__((ext_vector_type(2)));
                    f2 p[4]; const float rsq = rs * HQ_SCALE;
#pragma unroll
                    for (int n = 0; n < 2; ++n)
#pragma unroll
                        for (int h = 0; h < 2; ++h) { const float g0 = acc[ai][0][m][n][2 * h], g1 = acc[ai][0][m][n][2 * h + 1], u0 = acc[ai][1][m][n][2 * h], u1 = acc[ai][1][m][n][2 * h + 1];
                            const f2 gi = IACC ? (f2){(float)__float_as_int(g0), (float)__float_as_int(g1)} : (f2){g0, g1}, ui = IACC ? (f2){(float)__float_as_int(u0), (float)__float_as_int(u1)} : (f2){u0, u1};
                            const f2 gt = gi * rs, up = ui * rsq, ex = gt * -1.4426950408889634f;
                            const f2 den = (f2){__builtin_amdgcn_exp2f(ex.x), __builtin_amdgcn_exp2f(ex.y)} + 1.f;
                            const f2 sg = (f2){__builtin_amdgcn_rcpf(den.x), __builtin_amdgcn_rcpf(den.y)};
                            p[2 * n + h] = gt * sg * up; }
#pragma unroll
                    for (int i = 0; i < 4; ++i) p[i] = (f2){p[i].x + p[i].y, p[i].x - p[i].y};
                    { const f2 t0 = p[0], t2 = p[2]; p[0] = t0 + p[1]; p[1] = t0 - p[1]; p[2] = t2 + p[3]; p[3] = t2 - p[3]; }
                    { const f2 t0 = p[0], t1 = p[1]; p[0] = t0 + p[2]; p[2] = t0 - p[2]; p[1] = t1 + p[3]; p[3] = t1 - p[3]; }
                    { const float s16 = (fq & 1) ? -1.f : 1.f, s32 = (fq & 2) ? -1.f : 1.f;
#pragma unroll
                      for (int i = 0; i < 4; ++i) { const auto r0 = __builtin_amdgcn_permlane16_swap(__float_as_uint(p[i].x), __float_as_uint(p[i].x), false, false), r1 = __builtin_amdgcn_permlane16_swap(__float_as_uint(p[i].y), __float_as_uint(p[i].y), false, false);
                          p[i] = (f2){__uint_as_float(r0[0]), __uint_as_float(r1[0])} + (f2){__uint_as_float(r0[1]), __uint_as_float(r1[1])} * s16; }
#pragma unroll
                      for (int i = 0; i < 4; ++i) { const auto r0 = __builtin_amdgcn_permlane32_swap(__float_as_uint(p[i].x), __float_as_uint(p[i].x), false, false), r1 = __builtin_amdgcn_permlane32_swap(__float_as_uint(p[i].y), __float_as_uint(p[i].y), false, false);
                          p[i] = (f2){__uint_as_float(r0[0]), __uint_as_float(r1[0])} + (f2){__uint_as_float(r0[1]), __uint_as_float(r1[1])} * s32; } }
                    v2u w; w.x = pk4_i8(p[0].x, p[0].y, p[1].x, p[1].y); w.y = pk4_i8(p[2].x, p[2].y, p[3].x, p[3].y);
                    *(v2u*)((unsigned char*)H + (size_t)(row0 + ai * HALF + m * 16) * FF + col0) = w;
                    continue; }
#pragma unroll
                for (int n = 0; n < 2; ++n)
#pragma unroll
                    for (int j = 0; j < 4; ++j) { const float gf = acc[ai][0][m][n][j], uf = acc[ai][1][m][n][j];
                        const float ga = IACC ? (float)__float_as_int(gf) : gf, ua = IACC ? (float)__float_as_int(uf) : uf;
                        const float gt = ga * rs, up = ua * rs; o[4 * n + j] = gt * sigmoidf_(gt) * up; }
                if constexpr (HF == 2) {
#define HAD_BF(a, b) do { const float t_ = a; a = t_ + b; b = t_ - b; } while (0)
                    HAD_BF(o[0], o[1]); HAD_BF(o[2], o[3]); HAD_BF(o[4], o[5]); HAD_BF(o[6], o[7]);
                    HAD_BF(o[0], o[2]); HAD_BF(o[1], o[3]); HAD_BF(o[4], o[6]); HAD_BF(o[5], o[7]);
                    HAD_BF(o[0], o[4]); HAD_BF(o[1], o[5]); HAD_BF(o[2], o[6]); HAD_BF(o[3], o[7]);
#undef HAD_BF
                    { const float s16 = (fq & 1) ? -1.f : 1.f, s32 = (fq & 2) ? -1.f : 1.f;
#pragma unroll
                      for (int e = 0; e < 8; ++e) { const auto r = __builtin_amdgcn_permlane16_swap(__float_as_uint(o[e]), __float_as_uint(o[e]), false, false); o[e] = __uint_as_float(r[0]) + s16 * __uint_as_float(r[1]); }
#pragma unroll
                      for (int e = 0; e < 8; ++e) { const auto r = __builtin_amdgcn_permlane32_swap(__float_as_uint(o[e]), __float_as_uint(o[e]), false, false); o[e] = __uint_as_float(r[0]) + s32 * __uint_as_float(r[1]); } }
                    v2u w; w.x = pk4_i8(o[0] * HQ_SCALE, o[1] * HQ_SCALE, o[2] * HQ_SCALE, o[3] * HQ_SCALE); w.y = pk4_i8(o[4] * HQ_SCALE, o[5] * HQ_SCALE, o[6] * HQ_SCALE, o[7] * HQ_SCALE);
                    *(v2u*)((unsigned char*)H + (size_t)(row0 + ai * HALF + m * 16) * FF + col0) = w;
                } else if constexpr (HF == 1) {
#pragma unroll
                    for (int e = 0; e < 8; ++e) o[e] = __builtin_amdgcn_fmed3f(o[e] * H8_SCALE, -448.f, 448.f);
                    v2u w; w.x = pk4_fp8(o[0], o[1], o[2], o[3]); w.y = pk4_fp8(o[4], o[5], o[6], o[7]);
                    *(v2u*)((unsigned char*)H + (size_t)(row0 + ai * HALF + m * 16) * FF + col0) = w;
                } else {
                    v4u w; w.x = cvt_pk_bf16(o[0], o[1]); w.y = cvt_pk_bf16(o[2], o[3]); w.z = cvt_pk_bf16(o[4], o[5]); w.w = cvt_pk_bf16(o[6], o[7]);
                    *(v4u*)(H + (size_t)(row0 + ai * HALF + m * 16) * FF + col0) = w; }
            }
    }
};
struct EpiF32 {
    static constexpr bool PERM = false, HAS_RS = false;
    bf16* C; int ldc; float sc;
    __device__ __forceinline__ void operator()(AccT& acc, const Unit& u, int wr, int wc, int fr, int fq) const {
        const int row0 = u.pm * BM + wr * 64 + fr, col0 = u.pn * BM + wc * 32 + 4 * fq;
#pragma unroll
        for (int ai = 0; ai < 2; ++ai)
#pragma unroll
            for (int m = 0; m < 4; ++m) { bf16* rowp = C + (size_t)(row0 + ai * HALF + m * 16) * ldc + col0;
#pragma unroll
                for (int bj = 0; bj < 2; ++bj)
#pragma unroll
                    for (int n = 0; n < 2; ++n) { const pg8::f32x4 a = acc[ai][bj][m][n] * sc; v2u w; w.x = cvt_pk_bf16(a[0], a[1]); w.y = cvt_pk_bf16(a[2], a[3]); *(v2u*)(rowp + bj * HALF + n * 16) = w; } }
    }
};
struct EpiF32I {
    static constexpr bool PERM = false, HAS_RS = false;
    bf16* C; int ldc; float sc;
    __device__ __forceinline__ void operator()(AccT& acc, const Unit& u, int wr, int wc, int fr, int fq) const {
        const int row0 = u.pm * BM + wr * 64 + fr, col0 = u.pn * BM + wc * 32 + 4 * fq;
#pragma unroll
        for (int ai = 0; ai < 2; ++ai)
#pragma unroll
            for (int m = 0; m < 4; ++m) { bf16* rowp = C + (size_t)(row0 + ai * HALF + m * 16) * ldc + col0;
#pragma unroll
                for (int bj = 0; bj < 2; ++bj)
#pragma unroll
                    for (int n = 0; n < 2; ++n) { const pg8::f32x4 a = acc[ai][bj][m][n]; const float a0 = a[0], a1 = a[1], a2 = a[2], a3 = a[3];
                        const pg8::f32x4 f = (pg8::f32x4){(float)__float_as_int(a0), (float)__float_as_int(a1), (float)__float_as_int(a2), (float)__float_as_int(a3)} * sc;
                        v2u w; w.x = cvt_pk_bf16(f[0], f[1]); w.y = cvt_pk_bf16(f[2], f[3]);
                        *(v2u*)(rowp + bj * HALF + n * 16) = w; } }
    }
};
struct EpiProj {
    static constexpr bool PERM = true, HAS_RS = true;
    bf16* QKVX; bf16* SAB; const float* CS; const float* SN; float* KM; const float* RSc;
    __device__ __forceinline__ void store8(bf16* p, const float (&o)[8]) const {
        v4u w; w.x = cvt_pk_bf16(o[0], o[1]); w.y = cvt_pk_bf16(o[2], o[3]); w.z = cvt_pk_bf16(o[4], o[5]); w.w = cvt_pk_bf16(o[6], o[7]); *(v4u*)p = w; }
    __device__ __forceinline__ void load_rs(const Unit& u, int wr, int fr, float (&rsv)[8]) const {
#pragma unroll
        for (int i = 0; i < 8; ++i) rsv[i] = RSc[u.pm * BM + wr * 64 + fr + (i >> 2) * HALF + (i & 3) * 16]; }
    __device__ __forceinline__ void operator()(AccT& acc, const Unit& u, int wr, int wc, int fr, int fq, const float (&rsv)[8]) const {
        const int row0 = u.pm * BM + wr * 64 + fr, cw = wc * 32 + 8 * fq, pn = u.pn;
#pragma unroll
        for (int ai = 0; ai < 2; ++ai)
#pragma unroll
            for (int m = 0; m < 4; ++m) { const float rs = rsv[ai * 4 + m];
#pragma unroll
                for (int bj = 0; bj < 2; ++bj)
#pragma unroll
                    for (int n = 0; n < 2; ++n) acc[ai][bj][m][n] *= rs; }
        if (pn < 16) {
            bf16* dst = QKVX + (size_t)(pn >> 3) * ((size_t)M * AW); const int pr = pn & 7; const bool isk = pn >= 8;
            f32x4 ks[2][2];
#pragma unroll
            for (int bj = 0; bj < 2; ++bj)
#pragma unroll
                for (int n = 0; n < 2; ++n) ks[bj][n] = (f32x4){0.f, 0.f, 0.f, 0.f};
#pragma unroll
            for (int ai = 0; ai < 2; ++ai) {
                f32x4 csv[4], snv[4];
#pragma unroll
                for (int m = 0; m < 4; ++m) { const int s = (row0 + ai * HALF + m * 16) & (SEQ - 1);
                    csv[m] = *(const f32x4*)(CS + s * 64 + wc * 16 + 4 * fq); snv[m] = *(const f32x4*)(SN + s * 64 + wc * 16 + 4 * fq); }
#pragma unroll
                for (int m = 0; m < 4; ++m) { const int row = row0 + ai * HALF + m * 16; const f32x4 cs = csv[m], sn = snv[m];
#pragma unroll
                    for (int bj = 0; bj < 2; ++bj) { const f32x4 t1 = acc[ai][bj][m][0], t2 = acc[ai][bj][m][1];
                        const f32x4 o1 = t1 * cs - t2 * sn, o2 = t2 * cs + t1 * sn;
                        ks[bj][0] += o1; ks[bj][1] += o2;
                        float o[8] = {o1[0], o1[1], o1[2], o1[3], o2[0], o2[1], o2[2], o2[3]};
                        store8(dst + (size_t)row * AW + (pr * 2 + bj) * HD + cw, o); } }
                asm volatile("" ::: "memory"); }
            if (isk) {
#pragma unroll
                for (int bj = 0; bj < 2; ++bj)
#pragma unroll
                    for (int n = 0; n < 2; ++n) { f32x4 v = ks[bj][n];
#pragma unroll
                        for (int o = 1; o < 16; o <<= 1) { v[0] += __shfl_xor(v[0], o); v[1] += __shfl_xor(v[1], o); v[2] += __shfl_xor(v[2], o); v[3] += __shfl_xor(v[3], o); }
                        if (fr == 0) *(f32x4*)(KM + ((size_t)wr * 32 + u.pm) * AW + (pr * 2 + bj) * HD + cw + 4 * n) = v; }
            }
        } else if (pn < 40) {
            const int t = (pn - 16) >> 3, pr = pn & 7; bf16* dst = QKVX + (size_t)(pn >> 3) * ((size_t)M * AW);
#pragma unroll
            for (int ai = 0; ai < 2; ++ai)
#pragma unroll
                for (int m = 0; m < 4; ++m) { const int row = row0 + ai * HALF + m * 16;
#pragma unroll
                    for (int bj = 0; bj < 2; ++bj) { float o[8];
#pragma unroll
                        for (int n = 0; n < 2; ++n)
#pragma unroll
                            for (int j = 0; j < 4; ++j) { const float x = acc[ai][bj][m][n][j]; o[4 * n + j] = (t == 2) ? gelu_tanh(x) : x; }
                        store8(dst + (size_t)row * AW + pr * BM + bj * HALF + cw, o); } }
        } else {
            const int pr = (pn - 40) & 15; bf16* dst = SAB + (size_t)((pn - 40) >> 4) * ((size_t)M * DM);
#pragma unroll
            for (int ai = 0; ai < 2; ++ai)
#pragma unroll
                for (int m = 0; m < 4; ++m) { const int row = row0 + ai * HALF + m * 16;
#pragma unroll
                    for (int bj = 0; bj < 2; ++bj) { float o[8];
#pragma unroll
                        for (int n = 0; n < 2; ++n)
#pragma unroll
                            for (int j = 0; j < 4; ++j) o[4 * n + j] = sigmoidf_(acc[ai][bj][m][n][j]);
                        store8(dst + (size_t)row * DM + pr * BM + bj * HALF + cw, o); } }
        }
    }
};
constexpr int F1T = 86;
typedef float f2v __attribute__((ext_vector_type(2)));
constexpr int I8A0 = 0, I8A1 = 24, I8B0 = 40;
constexpr int GATE_PN0 = 40;
struct EpiGate {
    static constexpr bool PERM = true, HAS_RS = true;
    bf16* SAB; const float* RSc; float sc; bf16* QKVX;
    __device__ __forceinline__ void load_rs(const Unit& u, int wr, int fr, float (&rsv)[8]) const {
#pragma unroll
        for (int i = 0; i < 8; ++i) rsv[i] = RSc[u.pm * BM + wr * 64 + fr + (i >> 2) * HALF + (i & 3) * 16] * sc; }
    __device__ __forceinline__ void operator()(AccT& acc, const Unit& u, int wr, int wc, int fr, int fq, const float (&rsv)[8]) const {
        const int row0 = u.pm * BM + wr * 64 + fr, cw = wc * 32 + 8 * fq, pn = u.pn;
        if (pn < GATE_PN0) {
            const int t = (pn - 16) >> 3, pr8 = pn & 7; bf16* dq = QKVX + (size_t)(pn >> 3) * ((size_t)M * AW);
#pragma unroll
            for (int ai = 0; ai < 2; ++ai)
#pragma unroll
                for (int m = 0; m < 4; ++m) { const int row = row0 + ai * HALF + m * 16; const float rs = rsv[ai * 4 + m];
#pragma unroll
                    for (int bj = 0; bj < 2; ++bj) { f2v o[4];
#pragma unroll
                        for (int n = 0; n < 2; ++n)
#pragma unroll
                            for (int h = 0; h < 2; ++h) { const float a0 = acc[ai][bj][m][n][2 * h], a1 = acc[ai][bj][m][n][2 * h + 1];
                                const f2v x = (f2v){(float)__float_as_int(a0), (float)__float_as_int(a1)} * rs; o[2 * n + h] = (t == 2) ? (f2v){gelu_tanh(x.x), gelu_tanh(x.y)} : x; }
                        v4u w; w.x = cvt_pk_bf16(o[0].x, o[0].y); w.y = cvt_pk_bf16(o[1].x, o[1].y); w.z = cvt_pk_bf16(o[2].x, o[2].y); w.w = cvt_pk_bf16(o[3].x, o[3].y);
                        *(v4u*)(dq + (size_t)row * AW + pr8 * BM + bj * HALF + cw) = w; } }
            return; }
        const int pr = (pn - GATE_PN0) & 15; bf16* dst = SAB + (size_t)((pn - GATE_PN0) >> 4) * ((size_t)M * DM);
#pragma unroll
        for (int ai = 0; ai < 2; ++ai)
#pragma unroll
            for (int m = 0; m < 4; ++m) { const int row = row0 + ai * HALF + m * 16; const float rs = rsv[ai * 4 + m];
#pragma unroll
                for (int bj = 0; bj < 2; ++bj) { f2v o[4]; const float rsn = rs * -1.4426950408889634f;
#pragma unroll
                    for (int n = 0; n < 2; ++n)
#pragma unroll
                        for (int h = 0; h < 2; ++h) { const float a0 = acc[ai][bj][m][n][2 * h], a1 = acc[ai][bj][m][n][2 * h + 1];
                            const f2v ex = (f2v){(float)__float_as_int(a0), (float)__float_as_int(a1)} * rsn;
                            const f2v den = (f2v){__builtin_amdgcn_exp2f(ex.x), __builtin_amdgcn_exp2f(ex.y)} + 1.f;
                            o[2 * n + h] = (f2v){__builtin_amdgcn_rcpf(den.x), __builtin_amdgcn_rcpf(den.y)}; }
                    v4u w; w.x = cvt_pk_bf16(o[0].x, o[0].y); w.y = cvt_pk_bf16(o[1].x, o[1].y); w.z = cvt_pk_bf16(o[2].x, o[2].y); w.w = cvt_pk_bf16(o[3].x, o[3].y);
                    *(v4u*)(dst + (size_t)row * DM + pr * BM + bj * HALF + cw) = w; } }
    }
};
struct EpiProjI {
    static constexpr bool PERM = true, HAS_RS = true;
    EpiProj P; const float* RSq; float sc;
    __device__ __forceinline__ void load_rs(const Unit& u, int wr, int fr, float (&rsv)[8]) const {
#pragma unroll
        for (int i = 0; i < 8; ++i) rsv[i] = RSq[u.pm * BM + wr * 64 + fr + (i >> 2) * HALF + (i & 3) * 16] * sc; }
    __device__ __forceinline__ void operator()(AccT& acc, const Unit& u, int wr, int wc, int fr, int fq, const float (&rsv)[8]) const {
#pragma unroll
        for (int ai = 0; ai < 2; ++ai)
#pragma unroll
            for (int bj = 0; bj < 2; ++bj)
#pragma unroll
                for (int m = 0; m < 4; ++m)
#pragma unroll
                    for (int n = 0; n < 2; ++n) { const pg8::f32x4 a = acc[ai][bj][m][n]; const float a0 = a[0], a1 = a[1], a2 = a[2], a3 = a[3];
                        acc[ai][bj][m][n] = (pg8::f32x4){(float)__float_as_int(a0), (float)__float_as_int(a1), (float)__float_as_int(a2), (float)__float_as_int(a3)}; }
        P(acc, u, wr, wc, fr, fq, rsv);
    }
};
struct EpiMerge {
    static constexpr bool PERM = true, HAS_RS = false;
    const bf16* SA; const bf16* SB; bf16* MG;
    __device__ __forceinline__ void operator()(AccT& acc, const Unit& u, int wr, int wc, int fr, int fq) const {
        const int row0 = u.pm * BM + wr * 64 + fr, col0 = u.pn * BM + wc * 32 + 8 * fq;
#pragma unroll
        for (int ai = 0; ai < 2; ++ai) {
            const size_t rb = (size_t)(row0 + ai * HALF) * DM + col0;
            v4u bw[4][2];
#pragma unroll
            for (int m = 0; m < 4; ++m)
#pragma unroll
                for (int bj = 0; bj < 2; ++bj) bw[m][bj] = *(const v4u*)(SB + rb + (size_t)m * 16 * DM + bj * HALF);
            if (u.seg == 0) {
                v4u aw[4][2];
#pragma unroll
                for (int m = 0; m < 4; ++m)
#pragma unroll
                    for (int bj = 0; bj < 2; ++bj) aw[m][bj] = *(const v4u*)(SA + rb + (size_t)m * 16 * DM + bj * HALF);
#pragma unroll
                for (int m = 0; m < 4; ++m)
#pragma unroll
                    for (int bj = 0; bj < 2; ++bj) {
                        const v4u b = bw[m][bj], a = aw[m][bj];
                        const float sb[8] = {bflo(b.x), bfhi(b.x), bflo(b.y), bfhi(b.y), bflo(b.z), bfhi(b.z), bflo(b.w), bfhi(b.w)};
                        const float sa[8] = {bflo(a.x), bfhi(a.x), bflo(a.y), bfhi(a.y), bflo(a.z), bfhi(a.z), bflo(a.w), bfhi(a.w)};
#pragma unroll
                        for (int n = 0; n < 2; ++n) { const pg8::f32x4 sav = (pg8::f32x4){sa[4 * n], sa[4 * n + 1], sa[4 * n + 2], sa[4 * n + 3]};
                            const pg8::f32x4 rbv = (pg8::f32x4){__builtin_amdgcn_rcpf(sb[4 * n]), __builtin_amdgcn_rcpf(sb[4 * n + 1]), __builtin_amdgcn_rcpf(sb[4 * n + 2]), __builtin_amdgcn_rcpf(sb[4 * n + 3])};
                            acc[ai][bj][m][n] = acc[ai][bj][m][n] * (sav * rbv); }
                    }
            } else {
#pragma unroll
                for (int m = 0; m < 4; ++m)
#pragma unroll
                    for (int bj = 0; bj < 2; ++bj) {
                        const v4u b = bw[m][bj];
                        const float sb[8] = {bflo(b.x), bfhi(b.x), bflo(b.y), bfhi(b.y), bflo(b.z), bfhi(b.z), bflo(b.w), bfhi(b.w)};
                        const pg8::f32x4 o0 = acc[ai][bj][m][0] * (pg8::f32x4){sb[0], sb[1], sb[2], sb[3]}, o1 = acc[ai][bj][m][1] * (pg8::f32x4){sb[4], sb[5], sb[6], sb[7]};
                        v4u w; w.x = cvt_pk_bf16(o0[0], o0[1]); w.y = cvt_pk_bf16(o0[2], o0[3]); w.z = cvt_pk_bf16(o1[0], o1[1]); w.w = cvt_pk_bf16(o1[2], o1[3]);
                        *(v4u*)(MG + rb + (size_t)m * 16 * DM + bj * HALF) = w;
                    }
            }
            asm volatile("" ::: "memory");
        }
    }
};

struct Args {
    const float* in[24];
    float* out; unsigned char* ws;
    int ph_lo, ph_hi;
};
enum { I_X = 0, I_F1PRE, I_F1G, I_F1U, I_F1D, I_F1POST, I_MIXPRE, I_WIN, I_CONVW, I_CONVB, I_RGWA, I_RGBA, I_RGWX, I_RGBX, I_LAM,
       I_WAO, I_WRO, I_WO, I_MIXPOST, I_F2PRE, I_F2G, I_F2U, I_F2D, I_F2POST };

__device__ __forceinline__ int dest_row(int mode, int c) {
    if (mode == 0) return c;
    if (mode == 1) return (c >> 7) * 256 + (c & 127);
    if (mode == 2) return (c >> 7) * 256 + 128 + (c & 127);
    if (c >= 2 * AW) return c;
    const int d = c & 127, nn = d >> 6, rem = d & 63, wc = rem >> 4, fq = (rem >> 2) & 3, j = rem & 3;
    return (c & ~127) + 32 * wc + 8 * fq + 4 * nn + j;
}
__device__ __forceinline__ void p0_transpose_item(const float* W, int K, int N, bf16* WT, int mode, LAS float* scr, int item, int lane) {
    const int nblk = N / 32, kb = item / nblk, nb = item % nblk, k0 = 64 * kb, n0 = 32 * nb;
#pragma unroll 8
    for (int i = 0; i < 32; ++i) { const int kk = 2 * i + (lane >> 5); scr[kk * 33 + (lane & 31)] = W[(size_t)(k0 + kk) * N + n0 + (lane & 31)]; }
    LDS_WAIT(); asm volatile("" ::: "memory");
    const int c = lane & 7;
#pragma unroll
    for (int j = 0; j < 4; ++j) { const int n = (lane >> 3) + 8 * j; const LAS float* s = scr + (8 * c) * 33 + n;
        v4u o; o.x = pk2(s[0 * 33], s[1 * 33]); o.y = pk2(s[2 * 33], s[3 * 33]); o.z = pk2(s[4 * 33], s[5 * 33]); o.w = pk2(s[6 * 33], s[7 * 33]);
        const int dr = dest_row(mode, n0 + n);
        *(GAS v4u*)(WT + ((size_t)(dr >> 8) * (K >> 6) + kb) * 16384 + (dr & 255) * 64 + 8 * c) = o; }
    LDS_WAIT(); asm volatile("" ::: "memory");
}
__device__ __forceinline__ void p0_transpose_item64(const float* W, int K, int N, bf16* WT, int mode, LAS float* scr_, int item, int lane) {
    LAS unsigned* scr = (LAS unsigned*)scr_;
    const int nblk = N / 64, kb = item / nblk, nb = item % nblk, k0 = 64 * kb, n0 = 64 * nb;
    const int kr = lane >> 4, nq = lane & 15;
    const float* src = W + (size_t)(k0 + 2 * kr) * N + n0 + 4 * nq;
    f32x4 v0[8], v1[8];
#pragma unroll
    for (int p = 0; p < 8; ++p) { v0[p] = *(const f32x4*)(src + (size_t)(8 * p) * N); v1[p] = *(const f32x4*)(src + (size_t)(8 * p + 1) * N); }
#pragma unroll
    for (int p = 0; p < 8; ++p)
#pragma unroll
        for (int j = 0; j < 4; ++j) scr[(4 * nq + j) * 33 + 4 * p + kr] = pg8::cvt_pk_bf16(v0[p][j], v1[p][j]);
    LDS_WAIT(); asm volatile("" ::: "memory");
    const int nr = lane >> 3, c = lane & 7;
#pragma unroll
    for (int q = 0; q < 8; ++q) { const int n = 8 * q + nr; const LAS unsigned* t = scr + n * 33 + 4 * c;
        v4u o; o.x = t[0]; o.y = t[1]; o.z = t[2]; o.w = t[3];
        const int dr = dest_row(mode, n0 + n);
        *(GAS v4u*)(WT + ((size_t)(dr >> 8) * (K >> 6) + kb) * 16384 + (dr & 255) * 64 + 8 * c) = o; }
    LDS_WAIT(); asm volatile("" ::: "memory");
}
__device__ __forceinline__ int invperm32(int x) { return 16 * ((x >> 2) & 1) + 4 * (x >> 3) + (x & 3); }
template <int NBAT, bool NTS = false>
__device__ __forceinline__ void conv_stream_items(const float* W, int N, bf16* WT, int mode, bool perm, int K, int it, int stride, int nitems, int lane, const float* gain = nullptr, int col0 = 0, int ncb = 0) {
    const int nblk = ncb ? ncb : (N >> 8);
    float v[NBAT][4][8], gk[NBAT][8];
#pragma unroll
    for (int b = 0; b < NBAT; ++b) { const int i = it + b * stride, ic = i < nitems ? i : nitems - 1, kc = ic / nblk, nbk = ic - kc * nblk;
        const float* src = W + (size_t)(8 * kc) * N + col0 + 256 * nbk + lane;
#pragma unroll
        for (int e = 0; e < 8; ++e) gk[b][e] = gain ? gain[8 * kc + e] : 1.f;
#pragma unroll
        for (int j = 0; j < 4; ++j)
#pragma unroll
            for (int e = 0; e < 8; ++e) v[b][j][e] = __builtin_nontemporal_load(src + (size_t)e * N + 64 * j); }
#pragma unroll
    for (int b = 0; b < NBAT; ++b) { const int i = it + b * stride;
        if (i < nitems) { const int kc = i / nblk, nbk = i - kc * nblk;
#pragma unroll
            for (int j = 0; j < 4; ++j) { int r = dest_row(mode, col0 + 256 * nbk + lane + 64 * j); if (perm) r = (r & ~31) + invperm32(r & 31);
                v4u o; o.x = pg8::cvt_pk_bf16(v[b][j][0] * gk[b][0], v[b][j][1] * gk[b][1]); o.y = pg8::cvt_pk_bf16(v[b][j][2] * gk[b][2], v[b][j][3] * gk[b][3]);
                o.z = pg8::cvt_pk_bf16(v[b][j][4] * gk[b][4], v[b][j][5] * gk[b][5]); o.w = pg8::cvt_pk_bf16(v[b][j][6] * gk[b][6], v[b][j][7] * gk[b][7]);
                { GAS v4u* dp = (GAS v4u*)(WT + ((((size_t)(r >> 8) * (K >> 6) + (kc >> 3)) * 8 + (kc & 7)) * 256 + (r & 255)) * 8); if constexpr (NTS) __builtin_nontemporal_store(o, dp); else *dp = o; } } } }
}
template <int NBAT, bool NTS = false>
__device__ __forceinline__ void conv_stream_items8(const float* W, int N, unsigned char* WT, int K, int it, int stride, int nitems, int lane, float wscale, int mode = 0, bool perm = false, const float* gain = nullptr, int ncb = 0, size_t tile_bytes = 0, bool i8 = false, int col0 = 0) {
    const int nblk = ncb ? ncb : (N >> 7); const size_t tb = tile_bytes ? tile_bytes : (size_t)256 * K;
    float v[NBAT][2][16], gk[NBAT][16];
#pragma unroll
    for (int b = 0; b < NBAT; ++b) { const int i = it + b * stride, ic = i < nitems ? i : nitems - 1, kc = ic / nblk, nbk = ic - kc * nblk;
        const float* src = W + (size_t)(16 * kc) * N + col0 + 128 * nbk + lane;
#pragma unroll
        for (int e = 0; e < 16; ++e) gk[b][e] = gain ? gain[16 * kc + e] * wscale : wscale;
#pragma unroll
        for (int j = 0; j < 2; ++j)
#pragma unroll
            for (int e = 0; e < 16; ++e) v[b][j][e] = __builtin_nontemporal_load(src + (size_t)e * N + 64 * j); }
#pragma unroll
    for (int b = 0; b < NBAT; ++b) { const int i = it + b * stride;
        if (i < nitems) { const int kc = i / nblk, nbk = i - kc * nblk;
#pragma unroll
            for (int j = 0; j < 2; ++j) { int r = dest_row(mode, col0 + 128 * nbk + lane + 64 * j); if (perm) r = (r & ~31) + invperm32(r & 31);
                float q[16];
#pragma unroll
                for (int e = 0; e < 16; ++e) q[e] = v[b][j][e] * gk[b][e];
                v4u o;
                if (i8) { o.x = pk4_i8(q[0], q[1], q[2], q[3]); o.y = pk4_i8(q[4], q[5], q[6], q[7]); o.z = pk4_i8(q[8], q[9], q[10], q[11]); o.w = pk4_i8(q[12], q[13], q[14], q[15]); }
                else { o.x = pk4_fp8(q[0], q[1], q[2], q[3]); o.y = pk4_fp8(q[4], q[5], q[6], q[7]); o.z = pk4_fp8(q[8], q[9], q[10], q[11]); o.w = pk4_fp8(q[12], q[13], q[14], q[15]); }
                { GAS v4u* dp = (GAS v4u*)(WT + (size_t)(r >> 8) * tb + ((((size_t)(kc >> 3)) * 8 + (kc & 7)) * 256 + (r & 255)) * 16); if constexpr (NTS) __builtin_nontemporal_store(o, dp); else *dp = o; } } } }
}
template <int NBAT>
__device__ __forceinline__ void conv_had_items(const float* W, int N, unsigned char* WT, int K, int it, int stride, int nitems, int lane, float wscale) {
    const int nblk = N >> 6; const size_t tb = (size_t)256 * K;
    float v[NBAT][32];
#pragma unroll
    for (int b = 0; b < NBAT; ++b) { const int i = it + b * stride, ic = i < nitems ? i : nitems - 1, kc = ic / nblk, nbk = ic - kc * nblk;
        const float* src = W + (size_t)(32 * kc) * N + 64 * nbk + lane;
#pragma unroll
        for (int e = 0; e < 32; ++e) v[b][e] = __builtin_nontemporal_load(src + (size_t)e * N); }
#pragma unroll
    for (int b = 0; b < NBAT; ++b) { const int i = it + b * stride;
        if (i < nitems) { const int kc = i / nblk, nbk = i - kc * nblk, r = 64 * nbk + lane;
#pragma unroll
            for (int st = 1; st < 32; st <<= 1)
#pragma unroll
                for (int e = 0; e < 32; ++e) if (!(e & st)) { const float t = v[b][e]; v[b][e] = t + v[b][e + st]; v[b][e + st] = t - v[b][e + st]; }
#pragma unroll
            for (int h = 0; h < 2; ++h) { const int kc16 = 2 * kc + h; v4u o;
                o.x = pk4_i8(v[b][16 * h + 0] * wscale, v[b][16 * h + 1] * wscale, v[b][16 * h + 2] * wscale, v[b][16 * h + 3] * wscale);
                o.y = pk4_i8(v[b][16 * h + 4] * wscale, v[b][16 * h + 5] * wscale, v[b][16 * h + 6] * wscale, v[b][16 * h + 7] * wscale);
                o.z = pk4_i8(v[b][16 * h + 8] * wscale, v[b][16 * h + 9] * wscale, v[b][16 * h + 10] * wscale, v[b][16 * h + 11] * wscale);
                o.w = pk4_i8(v[b][16 * h + 12] * wscale, v[b][16 * h + 13] * wscale, v[b][16 * h + 14] * wscale, v[b][16 * h + 15] * wscale);
                *(GAS v4u*)(WT + (size_t)(r >> 8) * tb + ((((size_t)(kc16 >> 3)) * 8 + (kc16 & 7)) * 256 + (r & 255)) * 16) = o; } } }
}
__device__ __forceinline__ void rms_row_to_bf16(const float* xrow, const float* g, bf16* orow, int lane) {
    const f32x4* xr = (const f32x4*)xrow + lane; const f32x4* gr = (const f32x4*)g + lane;
    f32x4 v[16]; float s = 0.f;
#pragma unroll
    for (int j = 0; j < 16; ++j) { v[j] = xr[64 * j]; s += (v[j].x * v[j].x + v[j].y * v[j].y) + (v[j].z * v[j].z + v[j].w * v[j].w); }
    const float r = 1.f / sqrtf(wave_sum(s) * (1.f / DM) + EPS);
    v2u* o8 = (v2u*)orow + lane;
#pragma unroll
    for (int j = 0; j < 16; ++j) { const f32x4 gg = gr[64 * j]; v2u w; w.x = pk2(v[j].x * r * gg.x, v[j].y * r * gg.y); w.y = pk2(v[j].z * r * gg.z, v[j].w * r * gg.w); o8[64 * j] = w; }
}

template <int TM>
__device__ __forceinline__ void thin_phase(const bf16* FB, const bf16* XB, bf16* XR, float* RSo, float* out, const LAS f32x4* g1, int gw, int NGW, int lane, unsigned char* X8 = nullptr, float* RSq = nullptr) {
    constexpr float SC1 = (TM == 1) ? 1.f : 0.5f;
    const bf16* XS = (TM == 0) ? XB : XR;
    f32x4 va[16], vb[16]; v2u xh[16];
#define TH_LOAD(dst, mm) do { const v2u* fr_ = (const v2u*)(FB + (size_t)(mm) * DM) + lane; \
        _Pragma("unroll") for (int j = 0; j < 16; ++j) { const v2u w_ = fr_[64 * j]; dst[j] = (f32x4){bflo(w_.x), bfhi(w_.x), bflo(w_.y), bfhi(w_.y)}; } \
        { const v2u* xr_ = (const v2u*)(XS + (size_t)(mm) * DM) + lane; _Pragma("unroll") for (int j = 0; j < 16; ++j) xh[j] = xr_[64 * j]; } } while (0)
#define TH_ROW(cur, nxt, mm, mnext) do { float s = 0.f; \
        _Pragma("unroll") for (int j = 0; j < 16; ++j) s += (cur[j].x * cur[j].x + cur[j].y * cur[j].y) + (cur[j].z * cur[j].z + cur[j].w * cur[j].w); \
        const float r1 = SC1 / sqrtf(wave_sum(s) * (1.f / DM) + EPS); float s2 = 0.f, amax = 1e-20f; \
        asm volatile("" ::: "memory"); \
        _Pragma("unroll") for (int j = 0; j < 16; ++j) { const f32x4 xb = (f32x4){bflo(xh[j].x), bfhi(xh[j].x), bflo(xh[j].y), bfhi(xh[j].y)}; \
            cur[j] = xb + cur[j] * r1 * g1[64 * j + lane]; \
            if constexpr (TM == 2) { ((f32x4*)(out + (size_t)(mm) * DM) + lane)[64 * j] = cur[j]; } \
            else { v2u w; w.x = pg8::cvt_pk_bf16(cur[j].x, cur[j].y); w.y = pg8::cvt_pk_bf16(cur[j].z, cur[j].w); ((v2u*)(XR + (size_t)(mm) * DM) + lane)[64 * j] = w; \
                   const f32x4 q = (f32x4){bflo(w.x), bfhi(w.x), bflo(w.y), bfhi(w.y)}; s2 += (q.x * q.x + q.y * q.y) + (q.z * q.z + q.w * q.w); \
                   if constexpr (TM != 2) amax = fmaxf(fmaxf(amax, fmaxf(fabsf(cur[j].x), fabsf(cur[j].y))), fmaxf(fabsf(cur[j].z), fabsf(cur[j].w))); } } \
        asm volatile("" ::: "memory"); \
        if ((mnext) < M) TH_LOAD(nxt, mnext); \
        asm volatile("" ::: "memory"); \
        if constexpr (TM != 2) { const float r2 = 1.f / sqrtf(wave_sum(s2) * (1.f / DM) + EPS); \
            const float am = wave_max(amax), qs = 127.f / am; if (lane == 0) { RSo[mm] = r2; RSq[mm] = am * r2 * (1.f / 127.f); }        \
            _Pragma("unroll") for (int j = 0; j < 16; ++j) ((unsigned*)(X8 + (size_t)(mm) * DM) + lane)[64 * j] = pk4_i8(cur[j].x * qs, cur[j].y * qs, cur[j].z * qs, cur[j].w * qs); } \
        asm volatile("" ::: "memory"); } while (0)
    int m = gw;
    if (m < M) TH_LOAD(va, m);
    while (m < M) {
        int mn = m + NGW;
        TH_ROW(va, vb, m, mn);
        m = mn; if (m >= M) break; mn = m + NGW;
        TH_ROW(vb, va, m, mn);
        m = mn;
    }
#undef TH_LOAD
#undef TH_ROW
}

__global__ void __launch_bounds__(NTHR, 2) fwd(Args args) {
    extern __shared__ __attribute__((aligned(16))) unsigned char lds_raw[];
    LAS unsigned char* lds = (LAS unsigned char*)lds_raw;
    const int G = gridDim.x, bx = blockIdx.x;
    const int WV = __builtin_amdgcn_readfirstlane((int)threadIdx.x >> 6);
    const int vcu = (G % 8 == 0) ? (bx % 8) * (G / 8) + bx / 8 : bx;
    const int NGW = G * NWAVES;
#define PHASE_IDS() int tid = tid_of(WV); asm volatile("" : "+v"(tid)); const int lane = tid & 63, wave = __builtin_amdgcn_readfirstlane(tid >> 6), gw = vcu * NWAVES + wave; (void)lane; (void)gw
    unsigned char* ws = args.ws;
    unsigned* ctl = (unsigned*)(ws + WS_CTL);
    const int lo = args.ph_lo, hi = args.ph_hi;
    if (threadIdx.x < 4) ((LAS unsigned*)(lds + MISC_OFF))[threadIdx.x] = 0u;
    __syncthreads();
    XcdBarrier bar; bar.bar = ctl + CW_BAR; bar.x = 0; bar.st = nullptr; bar.wv = WV;
    if (hi - lo > 1) bar = xcd_barrier_post(ctl + CW_BAR, (volatile LAS unsigned*)(lds + MISC_OFF), WV);
#define IN(k) (lo <= (k) && (k) < hi)
#define SEAM(k) do { if (IN(k) && IN((k) + 1)) xcd_barrier(bar); } while (0)

    const float* x = args.in[I_X];
    bf16* WGU1 = (bf16*)(ws + WS_WGU1); bf16* WD1 = (bf16*)(ws + WS_WD1); bf16* WIN = (bf16*)(ws + WS_WIN);
    bf16* WAO = (bf16*)(ws + WS_WAO); bf16* WRO = (bf16*)(ws + WS_WRO); bf16* WOt = (bf16*)(ws + WS_WO);
    bf16* WGU2 = (bf16*)(ws + WS_WGU2); bf16* WD2 = (bf16*)(ws + WS_WD2);
    bf16* ACT = (bf16*)(ws + WS_ACT); bf16* HB = (bf16*)(ws + WS_H); bf16* FB = (bf16*)(ws + WS_F); bf16* XR = (bf16*)(ws + WS_XR);
    bf16* QB = (bf16*)(ws + WS_H); bf16* KB = QB + (size_t)M * AW; bf16* VB = KB + (size_t)M * AW; bf16* XREC = VB + (size_t)M * AW; bf16* XGATE = XREC + (size_t)M * AW;
    bf16* SAb = (bf16*)(ws + WS_F); bf16* SBb = SAb + (size_t)M * DM;
    bf16* ATT = ACT; bf16* YREC = ACT + (size_t)M * AW;
    bf16* MG = (bf16*)(ws + WS_MG);
    float* RS = (float*)(ws + WS_RS);
    float* CS = (float*)(ws + WS_ROPE); float* SN = CS + SEQ * 64; float* KM = (float*)(ws + WS_KM); float* SPt = (float*)(ws + WS_SP);

    if (IN(0)) {
        PHASE_IDS();
        constexpr int I_GU = (DM / 8) * (FF / 256), I_IN = (DM / 8) * (INC / 256), I_AO = (AW / 8) * (DM / 256), I_OO = (DM / 8) * (DM / 256);
#define CONV_ALL(Wsrc, Ncols, Wdst, mode_, perm_, K_, nit, gain_) for (int it = gw; it < (nit); it += 2 * NGW) conv_stream_items<2>(Wsrc, Ncols, Wdst, mode_, perm_, K_, it, NGW, nit, lane, gain_)
        { constexpr int C8 = 128 * F1T, NCB = (FF - C8) / 256, I_B = (DM / 8) * NCB, I_8 = (DM / 16) * F1T;
          for (int it = gw; it < I_8; it += 2 * NGW) conv_stream_items8<2>(args.in[I_F1G], FF, (unsigned char*)WGU1, DM, it, NGW, I_8, lane, WGI_SCALE, 1, true, args.in[I_F1PRE], F1T, (size_t)512 * DM, true);
          for (int it = gw; it < I_8; it += 2 * NGW) conv_stream_items8<2>(args.in[I_F1U], FF, (unsigned char*)WGU1, DM, it, NGW, I_8, lane, WGI_SCALE, 2, true, args.in[I_F1PRE], F1T, (size_t)512 * DM, true);
          if (NCB > 0) { for (int it = gw; it < I_B; it += 2 * NGW) conv_stream_items<2>(args.in[I_F1G], FF, WGU1, 1, true, DM, it, NGW, I_B, lane, args.in[I_F1PRE], C8, NCB);
                         for (int it = gw; it < I_B; it += 2 * NGW) conv_stream_items<2>(args.in[I_F1U], FF, WGU1, 2, true, DM, it, NGW, I_B, lane, args.in[I_F1PRE], C8, NCB); } }
#undef CONV_ALL
        for (int m = gw; m < M; m += NGW) {
            const f32x4* xr = (const f32x4*)(x + (size_t)m * DM) + lane; f32x4 v[16]; float ss = 0.f;
            float amax = 1e-20f;
#pragma unroll
            for (int j = 0; j < 16; ++j) { v[j] = xr[64 * j]; ss += (v[j].x * v[j].x + v[j].y * v[j].y) + (v[j].z * v[j].z + v[j].w * v[j].w);
                amax = fmaxf(fmaxf(amax, fmaxf(fabsf(v[j].x), fabsf(v[j].y))), fmaxf(fabsf(v[j].z), fabsf(v[j].w))); }
            const float r = 1.f / sqrtf(wave_sum(ss) * (1.f / DM) + EPS), am = wave_max(amax), qs = 127.f / am; if (lane == 0) { RS[m] = r; RS[5 * M + m] = am * r * (1.f / 127.f); }
#pragma unroll
            for (int j = 0; j < 16; ++j) ((unsigned*)((unsigned char*)MG + (size_t)m * DM) + lane)[64 * j] = pk4_i8(v[j].x * qs, v[j].y * qs, v[j].z * qs, v[j].w * qs);
            v2u* o8 = (v2u*)(ACT + (size_t)m * DM) + lane;
#pragma unroll
            for (int j = 0; j < 16; ++j) { v2u w; w.x = pg8::cvt_pk_bf16(v[j].x, v[j].y); w.y = pg8::cvt_pk_bf16(v[j].z, v[j].w); o8[64 * j] = w; }
        }
        const int gt = vcu * NTHR + tid, NGT = G * NTHR;
        for (int i = gt; i < SEQ * 64; i += NGT) { const int s = i >> 6, f = i & 63;
            const float inv = powf(10000.0f, -(float)(2 * f) / 128.0f); const float ang = (float)s * inv;
            const double a = (double)ang; const double k = rint(a * 0.15915494309189535); const float rr = (float)(a - k * 6.283185307179586);
            CS[i] = cosf(rr); SN[i] = sinf(rr); }
        for (int i = gt; i < LW; i += NGT) { const float xl = -args.in[I_LAM][i]; SPt[i] = fmaxf(xl, 0.f) + log1pf(expf(-fabsf(xl))); }
    }
    SEAM(0);
    if (IN(1)) {
        { const int xs = bx & 7;
          pg8::Gemm g = pg8::gemm_chunkB8(MG, WGU1, DM, DM, (size_t)512 * DM);
          EpiSwiGLU<2, true, true> E{HB, RS + 5 * M, 1.f / WGI_SCALE};
          { pg8::StaticOrder S; S.init(M, 256 * F1T, G, bx); S.iend = xs + 1;
            pg8::gemm_phase<EpiSwiGLU<2, true, true>, pg8::StaticOrder, 0, false, false, true>(lds + RING_OFF, g, S, E, WV); }
        { PHASE_IDS();
          constexpr int I_OO = (DM / 8) * (DM / 256);
#define CONV_ALL(Wsrc, Ncols, Wdst, mode_, perm_, K_, nit, gain_) for (int it = gw; it < (nit); it += 2 * NGW) conv_stream_items<2, true>(Wsrc, Ncols, Wdst, mode_, perm_, K_, it, NGW, nit, lane, gain_)
        {
            constexpr int IB1 = (DM / 8) * I8A0, IB2 = (DM / 8) * (I8B0 - I8A1), I81 = (DM / 16) * 2 * (I8A1 - I8A0), I82 = (DM / 16) * 2 * (INC / 256 - I8B0);
            for (int it = gw; it < IB1; it += 2 * NGW) conv_stream_items<2, true>(args.in[I_WIN], INC, WIN, 3, true, DM, it, NGW, IB1, lane, args.in[I_MIXPRE], 0, I8A0);
            if (IB2 > 0) for (int it = gw; it < IB2; it += 2 * NGW) conv_stream_items<2, true>(args.in[I_WIN], INC, WIN, 3, true, DM, it, NGW, IB2, lane, args.in[I_MIXPRE], 256 * I8A1, I8B0 - I8A1);
            if (I81 > 0) for (int it = gw; it < I81; it += 2 * NGW) conv_stream_items8<2, true>(args.in[I_WIN], INC, (unsigned char*)WIN, DM, it, NGW, I81, lane, WGI_SCALE, 3, true, args.in[I_MIXPRE], 2 * (I8A1 - I8A0), (size_t)512 * DM, true, 256 * I8A0);
            for (int it = gw; it < I82; it += 2 * NGW) conv_stream_items8<2, true>(args.in[I_WIN], INC, (unsigned char*)WIN, DM, it, NGW, I82, lane, WGI_SCALE, 3, true, args.in[I_MIXPRE], 2 * (INC / 256 - I8B0), (size_t)512 * DM, true, 256 * I8B0); }
        CONV_ALL(args.in[I_WO], DM, WOt, 0, false, DM, I_OO, nullptr);
        { constexpr int I_8 = (DM / 16) * (FF / 128);
          for (int it = gw; it < I_8; it += 2 * NGW) conv_stream_items8<2, true>(args.in[I_F2G], FF, (unsigned char*)WGU2, DM, it, NGW, I_8, lane, WGI_SCALE, 1, true, args.in[I_F2PRE], FF / 128, (size_t)256 * DM, true);
          for (int it = gw; it < I_8; it += 2 * NGW) conv_stream_items8<2, true>(args.in[I_F2U], FF, (unsigned char*)WGU2, DM, it, NGW, I_8, lane, WGI_SCALE, 2, true, args.in[I_F2PRE], FF / 128, (size_t)256 * DM, true); }
#undef CONV_ALL
        }
          { pg8::StaticOrder S; S.init(M, 256 * F1T, G, bx); S.ibeg = xs + 1;
            pg8::gemm_phase<EpiSwiGLU<2, true, true>, pg8::StaticOrder, 0, false, false, true>(lds + RING_OFF, g, S, E, WV); } }
        if (F1T < 2 * FF / 256) {
        pg8::Gemm g = pg8::gemm_chunkB(ACT, ACT, WGU1, WGU1, DM, DM, 2 * FF); pg8::StaticOrder S; S.init(M, 2 * FF - 256 * F1T, G, bx, F1T);
        EpiSwiGLU<2> E{HB, RS, 1.f};
        pg8::gemm_phase<EpiSwiGLU<2>, pg8::StaticOrder, 0, false>(lds + RING_OFF, g, S, E, WV); }
        { const int nun = (M / 256) * ((F1T < 2 * FF / 256) ? 2 * FF / 256 - F1T : 2 * FF / 256), full = nun % G; constexpr int NI = (FF / 32) * (DM / 64);
          PHASE_IDS();
          if (full != 0) { if (bx >= full) { const int nw = (G - full) * NWAVES;
              for (int it = (bx - full) * NWAVES + wave; it < NI; it += 2 * nw) conv_had_items<2>(args.in[I_F1D], DM, (unsigned char*)WD1, FF, it, nw, NI, lane, WQ_SCALE); } }
          else { for (int it = gw; it < NI; it += 2 * NGW) conv_had_items<2>(args.in[I_F1D], DM, (unsigned char*)WD1, FF, it, NGW, NI, lane, WQ_SCALE); } }
    }
    SEAM(1);
    if (IN(2)) {
        pg8::Gemm g = pg8::gemm_chunkB8(HB, WD1, FF, FF); pg8::StaticOrder S; S.init(M, DM, G, bx);
        EpiF32I E{FB, DM, DQ_SCALE};
        pg8::gemm_phase<EpiF32I, pg8::StaticOrder, 0, false, false, true>(lds + RING_OFF, g, S, E, WV);
    }
    SEAM(2);
    if (IN(3)) {
        PHASE_IDS();
        LAS f32x4* g1 = (LAS f32x4*)(lds + RING_OFF);
        for (int i = tid; i < DM / 4; i += NTHR) g1[i] = ((const f32x4*)args.in[I_F1POST])[i];
        __syncthreads();
        thin_phase<0>(FB, ACT, XR, RS + M, nullptr, g1, gw, NGW, lane, (unsigned char*)MG, RS + 3 * M);
        __syncthreads();
    }
    SEAM(3);
    if (IN(4)) {
        { pg8::Gemm g = pg8::gemm_chunkB8(MG, WIN, DM, DM, (size_t)512 * DM); EpiProjI E{EpiProj{QB, SAb, CS, SN, KM, RS + M}, RS + 3 * M, 1.f / WGI_SCALE};
          pg8::StaticOrder S; S.init(M, 256 * (I8A1 - I8A0) + INC - 256 * I8B0, G, bx, I8A0, I8A1 - I8A0, I8B0 - I8A1); pg8::gemm_phase<EpiProjI, pg8::StaticOrder, 0, false, false, true>(lds + RING_OFF, g, S, E, WV); }
        { pg8::Gemm g = pg8::gemm_chunkB(XR, XR, WIN, WIN, DM, DM, INC); EpiProj E{QB, SAb, CS, SN, KM, RS + M};
          pg8::StaticOrder S; S.init(M, 256 * (I8A0 + I8B0 - I8A1), G, bx, 0, I8A0, I8A1 - I8A0); pg8::gemm_phase<EpiProj, pg8::StaticOrder, 0, false>(lds + RING_OFF, g, S, E, WV); }
    }
    SEAM(4);
    if (IN(7)) {
        PHASE_IDS();
        {
            typedef att::bf16x8 bf8; typedef att::f32x16 f16v;
            LAS float* cwl = (LAS float*)(lds + RING_OFF);
            LAS float* summ = (LAS float*)(lds + RING_OFF + 4096);
            const float* cw = args.in[I_CONVW]; const float* cb = args.in[I_CONVB];
            static_assert(NB * 64 * 8 * 8 * 2 == 2 * (AW / 8) * (DM / 64), "hosted conversion groups");
            for (int unit = vcu; unit < NB * 64; unit += G) {
                const int b = unit >> 6, n = (unit >> 2) & 15, q = unit & 3, C0 = 128 * n + 32 * q;
                int tl = tid_of(WV); asm volatile("" : "+v"(tl));
                const int lane2 = tl & 63, d = lane2 & 31, hi = lane2 >> 5, wave2 = __builtin_amdgcn_readfirstlane(tl >> 6);
                LAS unsigned char* xs = lds + RING_OFF + 8192 + wave2 * 12288;
                LAS unsigned char* gs = xs + 9728; LAS unsigned char* ys = xs;
                __syncthreads();
                for (int i = tl; i < 5 * 128; i += NTHR) { const int tap = i >> 7, c = i & 127; cwl[i] = tap < 4 ? cw[tap * LW + 128 * n + c] : cb[128 * n + c]; }
                LAS v4u* wfr = (LAS v4u*)(lds + RING_OFF + 8192 + 8 * 12288);
                { const int ks = wave2; float wa[8], wx[8];
#pragma unroll
                    for (int e = 0; e < 8; ++e) { const size_t o = ((size_t)n * 128 + 16 * ks + 8 * hi + e) * 128 + 32 * q + d; wa[e] = args.in[I_RGWA][o]; wx[e] = args.in[I_RGWX][o]; }
                    v4u pa, px; pa.x = pg8::cvt_pk_bf16(wa[0], wa[1]); pa.y = pg8::cvt_pk_bf16(wa[2], wa[3]); pa.z = pg8::cvt_pk_bf16(wa[4], wa[5]); pa.w = pg8::cvt_pk_bf16(wa[6], wa[7]);
                    px.x = pg8::cvt_pk_bf16(wx[0], wx[1]); px.y = pg8::cvt_pk_bf16(wx[2], wx[3]); px.z = pg8::cvt_pk_bf16(wx[4], wx[5]); px.w = pg8::cvt_pk_bf16(wx[6], wx[7]);
                    wfr[(ks * 64 + lane2) * 2] = pa; wfr[(ks * 64 + lane2) * 2 + 1] = px; }
                const float bav = args.in[I_RGBA][C0 + d], bxv = args.in[I_RGBX][C0 + d], spv = SPt[C0 + d];
                float Sround = 0.f;
                v4u xq[9], gq[2];
#define LRU_LOAD(rho_) do { const int t0_ = 256 * (rho_) + 32 * wave2; \
                    _Pragma("unroll") for (int i_ = 0; i_ < 9; ++i_) { const int pc = lane2 + 64 * i_, rr = pc >> 4, c16 = pc & 15, ts = t0_ - 3 + rr; xq[i_] = (v4u){0u, 0u, 0u, 0u}; \
                        if (pc < 560 && ts >= 0) xq[i_] = *(const v4u*)(XREC + ((size_t)b * SEQ + ts) * LW + 128 * n + 8 * c16); } \
                    _Pragma("unroll") for (int i_ = 0; i_ < 2; ++i_) { const int pc = lane2 + 64 * i_, rr = pc >> 2, c16 = pc & 3; gq[i_] = *(const v4u*)(XGATE + ((size_t)b * SEQ + t0_ + rr) * LW + C0 + 8 * c16); } } while (0)
                LRU_LOAD(0);
                __syncthreads();
#pragma unroll 1
                for (int rho = 0; rho < 8; ++rho) {
                    const int t0 = 256 * rho + 32 * wave2;
#pragma unroll
                    for (int i_ = 0; i_ < 9; ++i_) { const int pc = lane2 + 64 * i_; if (pc < 560) *(LAS v4u*)(xs + (pc >> 4) * 272 + (pc & 15) * 16) = xq[i_]; }
#pragma unroll
                    for (int i_ = 0; i_ < 2; ++i_) { const int pc = lane2 + 64 * i_; *(LAS v4u*)(gs + (pc >> 2) * 80 + (pc & 3) * 16) = gq[i_]; }
                    if (rho < 7) LRU_LOAD(rho + 1);
                    float cvl[2][8]; const int cg0 = ((unit * 8 + rho) * 8 + wave2) * 2;
#pragma unroll
                    for (int gi = 0; gi < 2; ++gi) { const int gid = cg0 + gi, jm = gid >> 14, gl = gid & 16383, kc = gl >> 6, nbq = gl & 63;
                        const float* wsrc = (jm == 0 ? args.in[I_WAO] : args.in[I_WRO]) + (size_t)(8 * kc) * DM + 64 * nbq + lane2;
#pragma unroll
                        for (int e = 0; e < 8; ++e) cvl[gi][e] = wsrc[(size_t)e * DM]; }
                    LDS_WAIT();
                    f16v accA = {}, accX = {}, accI = {};
#pragma unroll
                    for (int ks = 0; ks < 8; ++ks) {
                        const int cc = 16 * ks + 8 * hi;
                        f2v xc[4];
                        { const f32x4 b0 = *(const LAS f32x4*)(cwl + 512 + cc), b1 = *(const LAS f32x4*)(cwl + 512 + cc + 4);
                          xc[0] = (f2v){b0.x, b0.y}; xc[1] = (f2v){b0.z, b0.w}; xc[2] = (f2v){b1.x, b1.y}; xc[3] = (f2v){b1.z, b1.w}; }
#pragma unroll
                        for (int tap = 0; tap < 4; ++tap) {
                            const v4u xw = *(const LAS v4u*)(xs + (d + tap) * 272 + cc * 2);
                            const f32x4 w0 = *(const LAS f32x4*)(cwl + tap * 128 + cc), w1 = *(const LAS f32x4*)(cwl + tap * 128 + cc + 4);
                            xc[0] += (f2v){w0.x, w0.y} * (f2v){bflo(xw.x), bfhi(xw.x)}; xc[1] += (f2v){w0.z, w0.w} * (f2v){bflo(xw.y), bfhi(xw.y)};
                            xc[2] += (f2v){w1.x, w1.y} * (f2v){bflo(xw.z), bfhi(xw.z)}; xc[3] += (f2v){w1.z, w1.w} * (f2v){bflo(xw.w), bfhi(xw.w)}; }
                        v4u af; af.x = pg8::cvt_pk_bf16(xc[0].x, xc[0].y); af.y = pg8::cvt_pk_bf16(xc[1].x, xc[1].y); af.z = pg8::cvt_pk_bf16(xc[2].x, xc[2].y); af.w = pg8::cvt_pk_bf16(xc[3].x, xc[3].y);
                        const bf8 Af = __builtin_bit_cast(bf8, af);
                        const int e1 = 32 * q + d - cc;
                        v4u idw; idw.x = (e1 == 0) ? 0x00003F80u : (e1 == 1 ? 0x3F800000u : 0u); idw.y = (e1 == 2) ? 0x00003F80u : (e1 == 3 ? 0x3F800000u : 0u);
                        idw.z = (e1 == 4) ? 0x00003F80u : (e1 == 5 ? 0x3F800000u : 0u); idw.w = (e1 == 6) ? 0x00003F80u : (e1 == 7 ? 0x3F800000u : 0u);
                        const bf8 Bak = __builtin_bit_cast(bf8, wfr[(ks * 64 + lane2) * 2]), Bxk = __builtin_bit_cast(bf8, wfr[(ks * 64 + lane2) * 2 + 1]);
                        accA = __builtin_amdgcn_mfma_f32_32x32x16_bf16(Af, Bak, accA, 0, 0, 0);
                        accX = __builtin_amdgcn_mfma_f32_32x32x16_bf16(Af, Bxk, accX, 0, 0, 0);
                        accI = __builtin_amdgcn_mfma_f32_32x32x16_bf16(Af, __builtin_bit_cast(bf8, idw), accI, 0, 0, 0);
                    }
                    float Pp[16], Hl[16], gA[4], gH[4];
#pragma unroll
                    for (int jp = 0; jp < 2; ++jp) {
                        constexpr float L2E = 1.4426950408889634f; const float c8 = -8.f * spv * L2E, c16 = -16.f * spv;
                        f2v pp = {1.f, 1.f}, hh = {0.f, 0.f};
#pragma unroll
                        for (int k = 0; k < 4; ++k) { const int r0 = 8 * jp + k, r1 = r0 + 4;
                            const f2v ea = ((f2v){accA[r0], accA[r1]} + bav) * -L2E, ex = ((f2v){accX[r0], accX[r1]} + bxv) * -L2E;
                            const f2v da = (f2v){__builtin_amdgcn_exp2f(ea.x), __builtin_amdgcn_exp2f(ea.y)} + 1.f, dx = (f2v){__builtin_amdgcn_exp2f(ex.x), __builtin_amdgcn_exp2f(ex.y)} + 1.f;
                            const f2v rg = {__builtin_amdgcn_rcpf(da.x), __builtin_amdgcn_rcpf(da.y)}, ig = {__builtin_amdgcn_rcpf(dx.x), __builtin_amdgcn_rcpf(dx.y)};
                            const f2v l2 = rg * c8, x = rg * c16;
                            const f2v av = {__builtin_amdgcn_exp2f(l2.x), __builtin_amdgcn_exp2f(l2.y)};
                            f2v p = x * 0.0013888889f + 0.0083333338f; p = p * x + 0.041666668f; p = p * x + 0.16666667f; p = p * x + 0.5f; p = p * x + 1.f; p = -x * p;
                            const f2v alt = 1.f - av * av;
                            const f2v ome = {x.x > -0.3f ? p.x : alt.x, x.y > -0.3f ? p.y : alt.y};
                            const f2v uv = (f2v){accI[r0], accI[r1]} * ig * (f2v){__builtin_amdgcn_sqrtf(ome.x), __builtin_amdgcn_sqrtf(ome.y)};
                            hh = av * hh + uv; pp = pp * av; Pp[r0] = pp.x; Pp[r1] = pp.y; Hl[r0] = hh.x; Hl[r1] = hh.y; }
                        gA[2 * jp] = pp.x; gA[2 * jp + 1] = pp.y; gH[2 * jp] = hh.x; gH[2 * jp + 1] = hh.y; }
                    float cin[4], pin[4]; float sl = 0.f, pl = 1.f;
#pragma unroll
                    for (int j = 0; j < 4; ++j) { const float oA = __shfl_xor(gA[j], 32), oH = __shfl_xor(gH[j], 32);
                        const float fA = hi ? oA : gA[j], fH = hi ? oH : gH[j], sA = hi ? gA[j] : oA, sH = hi ? gH[j] : oH;
                        const float c1 = sl, p1 = pl; sl = fA * sl + fH; pl *= fA; const float c2 = sl, p2 = pl; sl = sA * sl + sH; pl *= sA;
                        cin[j] = hi ? c2 : c1; pin[j] = hi ? p2 : p1; }
                    LAS float* sm = summ + (rho & 1) * 512;
                    if (hi == 0) { sm[wave2 * 64 + d] = pl; sm[wave2 * 64 + 32 + d] = sl; }
                    __syncthreads();
                    float s = Sround, myin = 0.f;
#pragma unroll
                    for (int w2 = 0; w2 < 8; ++w2) { const float A2 = sm[w2 * 64 + d], H2 = sm[w2 * 64 + 32 + d]; if (w2 == wave2) myin = s; s = A2 * s + H2; }
                    Sround = s;
#pragma unroll
                    for (int j = 0; j < 4; ++j) { const float ci = cin[j] + pin[j] * myin;
#pragma unroll
                        for (int k = 0; k < 4; ++k) { const int r = 4 * j + k, tr = k + 8 * j + 4 * hi;
                            const float h = Hl[r] + Pp[r] * ci;
                            const float gte = __builtin_bit_cast(float, (unsigned)*(const LAS unsigned short*)(gs + tr * 80 + d * 2) << 16);
                            *(LAS unsigned short*)(ys + tr * 80 + d * 2) = (unsigned short)f2bf(h * gte); } }
                    LDS_WAIT();
#pragma unroll
                    for (int i_ = 0; i_ < 2; ++i_) { const int pc = lane2 + 64 * i_, rr = pc >> 2, c16 = pc & 3;
                        *(v4u*)(YREC + ((size_t)b * SEQ + t0 + rr) * LW + C0 + 8 * c16) = *(const LAS v4u*)(ys + rr * 80 + c16 * 16); }
#pragma unroll
                    for (int gi = 0; gi < 2; ++gi) { const int gid = cg0 + gi, jm = gid >> 14, gl = gid & 16383, kc = gl >> 6, nbq = gl & 63;
                        int r = 64 * nbq + lane2; r = (r & ~31) + invperm32(r & 31);
                        bf16* wdst = jm == 0 ? WAO : WRO; const int Kj = AW;
                        v4u o; o.x = pg8::cvt_pk_bf16(cvl[gi][0], cvl[gi][1]); o.y = pg8::cvt_pk_bf16(cvl[gi][2], cvl[gi][3]); o.z = pg8::cvt_pk_bf16(cvl[gi][4], cvl[gi][5]); o.w = pg8::cvt_pk_bf16(cvl[gi][6], cvl[gi][7]);
                        *(GAS v4u*)(wdst + ((((size_t)(r >> 8) * (Kj >> 6) + (kc >> 3)) * 8 + (kc & 7)) * 256 + (r & 255)) * 8) = o; }
                }
#undef LRU_LOAD
            }
            __syncthreads();
        }
        {
            typedef unsigned short abf;
            char* alds = (char*)lds_raw;
            LAS float* kml = (LAS float*)(lds + 69632);
            LAS unsigned char* rmask = (LAS unsigned char*)(lds + 73728);
            for (int pr_ = vcu; pr_ < NB * NH * 4; pr_ += G) {
                const int bh = pr_ >> 2, j0 = pr_ & 3, b = bh / NH, h = bh % NH;
                int tg = tid_of(WV); asm volatile("" : "+v"(tg));
                {
                    const int jmax = 7 - j0;
                    __syncthreads();
                    for (int idx = tg; idx < jmax * 128; idx += NTHR) { const int n = idx >> 7, d = idx & 127; const size_t ko = ((size_t)(b * 8 + n)) * AW + h * HD + d;
                        kml[idx] = (KM[ko] + KM[(size_t)32 * AW + ko]) * (1.f / 256.f); }
                    __syncthreads();
                    const int pass = __builtin_amdgcn_readfirstlane(tg >> 8), row = tg & 255, jb = pass ? 7 - j0 : j0;
                    {
                        const v4u* qp = (const v4u*)(QB + ((size_t)b * SEQ + jb * 256 + row) * AW + h * HD);
                        float gsc[7];
#pragma unroll
                        for (int n = 0; n < 7; ++n) gsc[n] = 0.f;
#pragma unroll 2
                        for (int c = 0; c < 16; ++c) { const v4u qw = qp[c];
                            const float qv[8] = {bflo(qw.x), bfhi(qw.x), bflo(qw.y), bfhi(qw.y), bflo(qw.z), bfhi(qw.z), bflo(qw.w), bfhi(qw.w)};
#pragma unroll
                            for (int n = 0; n < 7; ++n) if (n < jb) { const f32x4 ka = *(const LAS f32x4*)(kml + n * 128 + 8 * c), kb = *(const LAS f32x4*)(kml + n * 128 + 8 * c + 4);
                                gsc[n] += qv[0] * ka.x + qv[1] * ka.y + qv[2] * ka.z + qv[3] * ka.w + qv[4] * kb.x + qv[5] * kb.y + qv[6] * kb.z + qv[7] * kb.w; } }
                        unsigned sel = 0u;
#pragma unroll
                        for (int k = 0; k < MOBA_TOPK; ++k) { int best = -1; float bv = -__builtin_inff();
#pragma unroll
                            for (int n = 0; n < 7; ++n) if (n < jb && !((sel >> n) & 1u) && gsc[n] > bv) { bv = gsc[n]; best = n; }
                            if (best >= 0) sel |= 1u << best; }
                        rmask[pass * 256 + row] = (unsigned char)sel;
                    }
                }
                __syncthreads();
                const abf* Qh = QB + (size_t)b * SEQ * AW + h * HD; const abf* Kh = KB + (size_t)b * SEQ * AW + h * HD; const abf* Vh = VB + (size_t)b * SEQ * AW + h * HD; abf* Oh = ATT + (size_t)b * SEQ * AW + h * HD;
                att::BlockRef<abf, abf> c0, c1;
                c0.Q = Qh + (size_t)(j0 * 256) * AW; c0.K = Kh; c0.V = Vh; c0.O = Oh + (size_t)(j0 * 256) * AW; c0.P0 = j0 * 256;
                c1.Q = Qh + (size_t)((7 - j0) * 256) * AW; c1.K = Kh; c1.V = Vh; c1.O = Oh + (size_t)((7 - j0) * 256) * AW; c1.P0 = (7 - j0) * 256;
                att::Seam<abf> Sm;
                att::causal_swa_prime<abf, abf>(c0, 1 << 30, alds, Sm, WV);
                att::causal_swa_block<abf, abf>(c0, c1, SEQ, 1 << 30, alds, Sm, (const LAS unsigned char*)(lds + 73728), WV);
                att::causal_swa_block<abf, abf>(c1, c1, SEQ, 1 << 30, alds, Sm, (const LAS unsigned char*)(lds + 73728 + 256), WV);
                __syncthreads();
            }
        }
    }
    SEAM(7);
    if (IN(8)) {
        pg8::Gemm g = pg8::gemm_chunkB(ATT, YREC, WAO, WRO, AW, AW, DM); pg8::StaticOrder2 S; S.init(M, DM, G, bx);
        EpiMerge E{SAb, SBb, MG};
        pg8::gemm_phase<EpiMerge, pg8::StaticOrder2, 1, false>(lds + RING_OFF, g, S, E, WV);
    }
    SEAM(8);
    if (IN(9)) {
        pg8::Gemm g = pg8::gemm_chunkB(MG, MG, WOt, WOt, DM, DM, DM); pg8::StaticOrder S; S.init(M, DM, G, bx);
        EpiF32 E{FB, DM, 1.f};
        pg8::gemm_phase<EpiF32, pg8::StaticOrder, 0, false>(lds + RING_OFF, g, S, E, WV);
    }
    SEAM(9);
    if (IN(10)) {
        PHASE_IDS();
        LAS f32x4* g1 = (LAS f32x4*)(lds + RING_OFF);
        for (int i = tid; i < DM / 4; i += NTHR) g1[i] = ((const f32x4*)args.in[I_MIXPOST])[i];
        __syncthreads();
        thin_phase<1>(FB, nullptr, XR, RS + 2 * M, nullptr, g1, gw, NGW, lane, (unsigned char*)ACT, RS + 4 * M);
        __syncthreads();
    }
    SEAM(10);
    if (IN(11)) {
        pg8::Gemm g = pg8::gemm_chunkB8(ACT, WGU2, DM, DM, (size_t)256 * DM); pg8::StaticOrder S; S.init(M, 2 * FF, G, bx);
        EpiSwiGLU<2, true, true> E{HB, RS + 4 * M, 1.f / WGI_SCALE};
        pg8::gemm_phase<EpiSwiGLU<2, true, true>, pg8::StaticOrder, 0, false, false, true>(lds + RING_OFF, g, S, E, WV);
        { const int nun = (M / 256) * (2 * FF / 256), full = nun % G; constexpr int NI = (FF / 32) * (DM / 64);
          PHASE_IDS();
          if (full != 0) { if (bx >= full) { const int nw = (G - full) * NWAVES;
              for (int it = (bx - full) * NWAVES + wave; it < NI; it += 2 * nw) conv_had_items<2>(args.in[I_F2D], DM, (unsigned char*)WD2, FF, it, nw, NI, lane, WQ_SCALE); } }
          else { for (int it = gw; it < NI; it += 2 * NGW) conv_had_items<2>(args.in[I_F2D], DM, (unsigned char*)WD2, FF, it, NGW, NI, lane, WQ_SCALE); } }
    }
    SEAM(11);
    if (IN(12)) {
        pg8::Gemm g = pg8::gemm_chunkB8(HB, WD2, FF, FF); pg8::StaticOrder S; S.init(M, DM, G, bx);
        EpiF32I E{FB, DM, DQ_SCALE};
        pg8::gemm_phase<EpiF32I, pg8::StaticOrder, 0, false, false, true>(lds + RING_OFF, g, S, E, WV);
    }
    SEAM(12);
    if (IN(13)) {
        PHASE_IDS();
        LAS f32x4* g1 = (LAS f32x4*)(lds + RING_OFF);
        for (int i = tid; i < DM / 4; i += NTHR) g1[i] = ((const f32x4*)args.in[I_F2POST])[i];
        __syncthreads();
        thin_phase<2>(FB, nullptr, XR, nullptr, args.out, g1, gw, NGW, lane);
    }
#undef IN
#undef SEAM
}
constexpr int NPHASE = 14;

extern "C" void kernel_launch(void* const* d_in, const int* in_sizes, int n_in, void* d_out, int out_size, void* d_ws, size_t ws_size, hipStream_t stream) {
    static int grid = 0;
    if (grid == 0) {
        if (n_in != 24 || in_sizes[0] != M * DM || out_size != M * DM || ws_size < WS_END) { fprintf(stderr, "kernel_launch: unexpected shapes (n_in %d, in0 %d, out %d, ws %zu); nothing launched\n", n_in, n_in > 0 ? in_sizes[0] : -1, out_size, ws_size); grid = -1; return; }
        int dev = 0, cus = 0, per_cu = 0;
        if (hipGetDevice(&dev) != hipSuccess || hipDeviceGetAttribute(&cus, hipDeviceAttributeMultiprocessorCount, dev) != hipSuccess) { grid = -1; return; }
        if (hipFuncSetAttribute((const void*)fwd, hipFuncAttributeMaxDynamicSharedMemorySize, LDS_BYTES) != hipSuccess) { fprintf(stderr, "kernel_launch: hipFuncSetAttribute failed\n"); grid = -1; return; }
        if (hipOccupancyMaxActiveBlocksPerMultiprocessor(&per_cu, (const void*)fwd, NTHR, LDS_BYTES) != hipSuccess || per_cu < 1) fprintf(stderr, "kernel_launch: occupancy query reports %d\n", per_cu);
        (void)hipGetLastError();
        grid = cus;
    }
    if (grid < 0) return;
    if (hipMemsetAsync((char*)d_ws + WS_CTL, 0, CTL_ZERO_BYTES, stream) != hipSuccess) return;
    Args a{};
    for (int i = 0; i < 24; ++i) a.in[i] = (const float*)d_in[i];
    a.out = (float*)d_out; a.ws = (unsigned char*)d_ws;
#if MK_PER_PHASE
    for (int p = 0; p < NPHASE; ++p) { a.ph_lo = p; a.ph_hi = p + 1; hipLaunchKernelGGL(fwd, dim3(grid), dim3(NTHR), LDS_BYTES, stream, a); }
#else
    a.ph_lo = 0; a.ph_hi = NPHASE; hipLaunchKernelGGL(fwd, dim3(grid), dim3(NTHR), LDS_BYTES, stream, a);
#endif
    const hipError_t le = hipPeekAtLastError();
    if (le != hipSuccess) fprintf(stderr, "kernel_launch: launch failed: %s\n", hipGetErrorName(le));
}
```
